# Optimizing an MI355X kernel written in HIP

```python
import jax, jax.numpy as jnp
from jax import lax
import numpy as np

D_MODEL = 1024
BATCH = 2
SEQ = 16384
DEPTH = 2

N_MIXERS = 2
ALPHA = (2 * DEPTH) ** 0.25
BETA = (8 * DEPTH) ** -0.25
LN_EPS = 1e-5
D_FF = 2816
GM_WIDTH = 3 * D_MODEL
GM_CHUNK = 128
GM_GROUPS = 16
GM_GCH = GM_WIDTH // GM_GROUPS
HEAD_DIM = 64
N_HEADS = D_MODEL // HEAD_DIM
N_KV = 4
HPG = N_HEADS // N_KV
CMP_BLOCK = 32
CMP_STRIDE = 16
CMP_HIDDEN = 256
SLC_BLOCK = 64
SLC_TOP = 16
WINDOW = 512
Q_BLOCK = 128
ROPE_THETA = 10000.0
NEG = -1e30
NSA_COLS = N_HEADS * HEAD_DIM + 6 * N_KV * HEAD_DIM + 3 * N_HEADS

kernel_name = 'hybrid_gmlp_nsa_macaron_deepnorm'


def layer_norm(x, g, b):
    xf = x.astype(jnp.float32)
    mu = xf.mean(-1, keepdims=True)
    var = jnp.square(xf - mu).mean(-1, keepdims=True)
    return ((xf - mu) * lax.rsqrt(var + LN_EPS) * g.astype(jnp.float32) + b.astype(jnp.float32)).astype(x.dtype)


def swiglu(x, w_in, w_out):
    gate, up = jnp.split(x @ w_in, 2, axis=-1)
    return (jax.nn.silu(gate) * up) @ w_out


def rope(x, pos):
    half = x.shape[-1] // 2
    freq = ROPE_THETA ** (-jnp.arange(half, dtype=jnp.float32) / half)
    ang = pos.astype(jnp.float32)[:, None] * freq
    shape = (pos.shape[0],) + (1,) * (x.ndim - 3) + (half,)
    cos = jnp.cos(ang).reshape(shape)
    sin = jnp.sin(ang).reshape(shape)
    xf = x.astype(jnp.float32)
    x1, x2 = xf[..., :half], xf[..., half:]
    return jnp.concatenate([x1 * cos - x2 * sin, x2 * cos + x1 * sin], axis=-1).astype(x.dtype)


def masked_softmax(s, mask):
    p = jax.nn.softmax(jnp.where(mask, s, NEG), axis=-1)
    return p * jnp.any(mask, axis=-1, keepdims=True)


def chunked_gmlp(x, w_in, ln_g, ln_b, w_s, b_s, w_out):
    B_, S_, _ = x.shape
    u, v = jnp.split(jax.nn.gelu(x @ w_in), 2, axis=-1)
    v = layer_norm(v, ln_g, ln_b)
    v = v.reshape(B_, S_ // GM_CHUNK, GM_CHUNK, GM_GROUPS, GM_GCH)
    causal = jnp.tril(jnp.ones((GM_CHUNK, GM_CHUNK), dtype=bool))
    w = jnp.where(causal, w_s, 0)
    v = jnp.einsum('gts,bnsgc->bntgc', w, v) + b_s.T[:, :, None]
    return (u * v.reshape(B_, S_, GM_WIDTH)) @ w_out


def nsa(x, w_in, cmp_pe_k, cmp_w1_k, cmp_w2_k, cmp_pe_v, cmp_w1_v, cmp_w2_v, w_out):
    B_, S_, _ = x.shape
    dt = x.dtype
    kvw = N_KV * HEAD_DIM
    splits = np.cumsum([N_HEADS * HEAD_DIM] + [kvw] * 6).tolist()
    q, k_c, v_c, k_s, v_s, k_w, v_w, g = jnp.split(x @ w_in, splits, axis=-1)
    kv = lambda t: t.reshape(B_, S_, N_KV, HEAD_DIM)
    pos = jnp.arange(S_)
    q = rope(q.reshape(B_, S_, N_KV, HPG, HEAD_DIM), pos)
    k_s = rope(kv(k_s), pos)
    k_w = rope(kv(k_w), pos)
    v_s, v_w = kv(v_s), kv(v_w)
    gates = jax.nn.sigmoid(g.astype(jnp.float32)).reshape(B_, S_, N_KV, HPG, 3).astype(dt)

    n_cmp = S_ // CMP_STRIDE - 1

    def compress(t, pe, w1, w2):
        ch = kv(t).reshape(B_, S_ // CMP_STRIDE, CMP_STRIDE, N_KV, HEAD_DIM)
        blk = jnp.concatenate([ch[:, :-1], ch[:, 1:]], axis=2) + pe[:, None, :]
        h = jax.nn.gelu(jnp.einsum('bnlgd,ldh->bngh', blk, w1))
        return h @ w2

    cmp_end = CMP_STRIDE * jnp.arange(n_cmp) + CMP_BLOCK - 1
    k_cmp = rope(compress(k_c, cmp_pe_k, cmp_w1_k, cmp_w2_k), cmp_end)
    v_cmp = compress(v_c, cmp_pe_v, cmp_w1_v, cmp_w2_v)

    n_slc = S_ // SLC_BLOCK
    n_top = min(SLC_TOP, n_slc)
    r = SLC_BLOCK // CMP_STRIDE
    k_sb = k_s.reshape(B_, n_slc, SLC_BLOCK, N_KV, HEAD_DIM)
    v_sb = v_s.reshape(B_, n_slc, SLC_BLOCK, N_KV, HEAD_DIM)
    k_wp = jnp.pad(k_w, ((0, 0), (WINDOW, 0), (0, 0), (0, 0)))
    v_wp = jnp.pad(v_w, ((0, 0), (WINDOW, 0), (0, 0), (0, 0)))
    scale = HEAD_DIM ** -0.5
    bi = jnp.arange(B_)[:, None, None, None]
    gi = jnp.arange(N_KV)[None, None, :, None]
    slc_ids = jnp.arange(n_slc)[None, :]
    n_qb = S_ // Q_BLOCK

    def block(args):
        qb_idx, qb, gb = args
        t = qb_idx * Q_BLOCK + jnp.arange(Q_BLOCK)
        s = jnp.einsum('bqghd,bngd->bqghn', qb, k_cmp).astype(jnp.float32) * scale
        p_cmp = masked_softmax(s, (cmp_end[None, :] <= t[:, None])[None, :, None, None, :])
        o_cmp = jnp.einsum('bqghn,bngd->bqghd', p_cmp.astype(dt), v_cmp)
        imp = jnp.pad(p_cmp.sum(axis=3), ((0, 0), (0, 0), (0, 0), (1, 1)))
        imp = imp[..., :r * n_slc].reshape(B_, Q_BLOCK, N_KV, n_slc, r).sum(-1) + imp[..., r::r]
        cur = (t // SLC_BLOCK)[:, None]
        forced = (slc_ids == 0) | (slc_ids == cur) | (slc_ids == cur - 1)
        imp = jnp.where(forced[:, None, :], 1e9, jnp.where((slc_ids <= cur)[:, None, :], imp, -1e9))
        _, idx = lax.top_k(imp, n_top)
        k_sel = k_sb[bi, idx, :, gi, :]
        v_sel = v_sb[bi, idx, :, gi, :].reshape(B_, Q_BLOCK, N_KV, n_top * SLC_BLOCK, HEAD_DIM)
        key_pos = idx[..., None] * SLC_BLOCK + jnp.arange(SLC_BLOCK)
        m_sel = (key_pos <= t[None, :, None, None, None]).reshape(B_, Q_BLOCK, N_KV, 1, n_top * SLC_BLOCK)
        s = jnp.einsum('bqghd,bqgnld->bqghnl', qb, k_sel).astype(jnp.float32)
        s = s.reshape(B_, Q_BLOCK, N_KV, HPG, n_top * SLC_BLOCK) * scale
        o_slc = jnp.einsum('bqghm,bqgmd->bqghd', masked_softmax(s, m_sel).astype(dt), v_sel)
        k_win = lax.dynamic_slice_in_dim(k_wp, qb_idx * Q_BLOCK, WINDOW + Q_BLOCK, axis=1)
        v_win = lax.dynamic_slice_in_dim(v_wp, qb_idx * Q_BLOCK, WINDOW + Q_BLOCK, axis=1)
        s_pos = (qb_idx * Q_BLOCK - WINDOW + jnp.arange(WINDOW + Q_BLOCK))[None, :]
        m_win = (s_pos <= t[:, None]) & (s_pos > t[:, None] - WINDOW) & (s_pos >= 0)
        s = jnp.einsum('bqghd,bkgd->bqghk', qb, k_win).astype(jnp.float32) * scale
        o_win = jnp.einsum('bqghk,bkgd->bqghd', masked_softmax(s, m_win[None, :, None, None, :]).astype(dt), v_win)
        return gb[..., 0:1] * o_cmp + gb[..., 1:2] * o_slc + gb[..., 2:3] * o_win

    q_blocks = q.reshape(B_, n_qb, Q_BLOCK, N_KV, HPG, HEAD_DIM).swapaxes(0, 1)
    g_blocks = gates.reshape(B_, n_qb, Q_BLOCK, N_KV, HPG, 3).swapaxes(0, 1)
    o = lax.map(block, (jnp.arange(n_qb), q_blocks, g_blocks))
    return o.swapaxes(0, 1).reshape(B_, S_, N_HEADS * HEAD_DIM) @ w_out


def _normal(key, shape, scale):
    return jax.random.normal(key, shape, jnp.float32) * scale


def _ln(key, n):
    kg, kb = jax.random.split(key)
    return 1.0 + _normal(kg, (n,), 0.01), _normal(kb, (n,), 0.01)


def _layer(key, pre, mixer):
    ks = jax.random.split(key, 20)
    p = {}
    p[pre + 'ffn1_w_in'] = _normal(ks[0], (D_MODEL, 2 * D_FF), D_MODEL ** -0.5)
    p[pre + 'ffn1_w_out'] = _normal(ks[1], (D_FF, D_MODEL), BETA * D_FF ** -0.5)
    p[pre + 'ln1_g'], p[pre + 'ln1_b'] = _ln(ks[2], D_MODEL)
    if mixer == 0:
        p[pre + 'gm_w_in'] = _normal(ks[3], (D_MODEL, 2 * GM_WIDTH), D_MODEL ** -0.5)
        p[pre + 'gm_ln_g'], p[pre + 'gm_ln_b'] = _ln(ks[4], GM_WIDTH)
        p[pre + 'gm_w_s'] = _normal(ks[5], (GM_GROUPS, GM_CHUNK, GM_CHUNK), GM_CHUNK ** -0.5)
        p[pre + 'gm_b_s'] = 1.0 + _normal(ks[6], (GM_GROUPS, GM_CHUNK), 0.1)
        p[pre + 'gm_w_out'] = _normal(ks[7], (GM_WIDTH, D_MODEL), BETA * GM_WIDTH ** -0.5)
    else:
        p[pre + 'nsa_w_in'] = _normal(ks[3], (D_MODEL, NSA_COLS), D_MODEL ** -0.5)
        p[pre + 'nsa_cmp_pe_k'] = _normal(ks[4], (CMP_BLOCK, HEAD_DIM), 0.1)
        p[pre + 'nsa_cmp_w1_k'] = _normal(ks[5], (CMP_BLOCK, HEAD_DIM, CMP_HIDDEN), (CMP_BLOCK * HEAD_DIM) ** -0.5)
        p[pre + 'nsa_cmp_w2_k'] = _normal(ks[6], (CMP_HIDDEN, HEAD_DIM), CMP_HIDDEN ** -0.5)
        p[pre + 'nsa_cmp_pe_v'] = _normal(ks[7], (CMP_BLOCK, HEAD_DIM), 0.1)
        p[pre + 'nsa_cmp_w1_v'] = _normal(ks[8], (CMP_BLOCK, HEAD_DIM, CMP_HIDDEN), (CMP_BLOCK * HEAD_DIM) ** -0.5)
        p[pre + 'nsa_cmp_w2_v'] = _normal(ks[9], (CMP_HIDDEN, HEAD_DIM), CMP_HIDDEN ** -0.5)
        p[pre + 'nsa_w_out'] = _normal(ks[10], (N_HEADS * HEAD_DIM, D_MODEL), BETA * (N_HEADS * HEAD_DIM) ** -0.5)
    p[pre + 'ln2_g'], p[pre + 'ln2_b'] = _ln(ks[11], D_MODEL)
    p[pre + 'ffn2_w_in'] = _normal(ks[12], (D_MODEL, 2 * D_FF), D_MODEL ** -0.5)
    p[pre + 'ffn2_w_out'] = _normal(ks[13], (D_FF, D_MODEL), BETA * D_FF ** -0.5)
    p[pre + 'ln3_g'], p[pre + 'ln3_b'] = _ln(ks[14], D_MODEL)
    return p


def setup_inputs(seed: int = 0) -> dict:
    key = jax.random.key(seed)
    kx, k0, k1 = jax.random.split(key, 3)
    out = {'x': jax.random.normal(kx, (BATCH, SEQ, D_MODEL), jnp.float32)}
    out.update(_layer(k0, 'l0_', 0))
    out.update(_layer(k1, 'l1_', 1))
    return out


def reference(x, l0_ffn1_w_in, l0_ffn1_w_out, l0_ln1_g, l0_ln1_b, l0_gm_w_in, l0_gm_ln_g, l0_gm_ln_b, l0_gm_w_s, l0_gm_b_s, l0_gm_w_out, l0_ln2_g, l0_ln2_b, l0_ffn2_w_in, l0_ffn2_w_out, l0_ln3_g, l0_ln3_b, l1_ffn1_w_in, l1_ffn1_w_out, l1_ln1_g, l1_ln1_b, l1_nsa_w_in, l1_nsa_cmp_pe_k, l1_nsa_cmp_w1_k, l1_nsa_cmp_w2_k, l1_nsa_cmp_pe_v, l1_nsa_cmp_w1_v, l1_nsa_cmp_w2_v, l1_nsa_w_out, l1_ln2_g, l1_ln2_b, l1_ffn2_w_in, l1_ffn2_w_out, l1_ln3_g, l1_ln3_b):
    layers = (
        dict(ffn1=(l0_ffn1_w_in, l0_ffn1_w_out), ln1=(l0_ln1_g, l0_ln1_b),
             mixer=(l0_gm_w_in, l0_gm_ln_g, l0_gm_ln_b, l0_gm_w_s, l0_gm_b_s, l0_gm_w_out),
             ln2=(l0_ln2_g, l0_ln2_b), ffn2=(l0_ffn2_w_in, l0_ffn2_w_out), ln3=(l0_ln3_g, l0_ln3_b)),
        dict(ffn1=(l1_ffn1_w_in, l1_ffn1_w_out), ln1=(l1_ln1_g, l1_ln1_b),
             mixer=(l1_nsa_w_in, l1_nsa_cmp_pe_k, l1_nsa_cmp_w1_k, l1_nsa_cmp_w2_k,
                    l1_nsa_cmp_pe_v, l1_nsa_cmp_w1_v, l1_nsa_cmp_w2_v, l1_nsa_w_out),
             ln2=(l1_ln2_g, l1_ln2_b), ffn2=(l1_ffn2_w_in, l1_ffn2_w_out), ln3=(l1_ln3_g, l1_ln3_b)),
    )
    for i in range(DEPTH):
        p = layers[i]
        x = layer_norm(ALPHA * x + 0.5 * swiglu(x, *p['ffn1']), *p['ln1'])
        if i % N_MIXERS == 0:
            mix = chunked_gmlp(x, *p['mixer'])
        else:
            mix = nsa(x, *p['mixer'])
        x = layer_norm(ALPHA * x + mix, *p['ln2'])
        x = layer_norm(ALPHA * x + 0.5 * swiglu(x, *p['ffn2']), *p['ln3'])
    return x
```

```cpp
#include <hip/hip_runtime.h>
#include <cstdio>
#include <cstdint>
namespace pg8 {
#define PG8_LAS __attribute__((address_space(3)))
typedef unsigned short bf16_t;
typedef short bf16x8 __attribute__((ext_vector_type(8)));
typedef float f32x4 __attribute__((ext_vector_type(4)));
typedef unsigned u32x4 __attribute__((ext_vector_type(4)));
constexpr int BM = 256, BK = 64, HALF = 128, HTB = HALF * BK * 2  , STAGE_BYTES = 8 * HTB, NXCD = 8, WGM = 8;

__host__ __device__ __forceinline__ int lds_byte(int r, int c) { const int st = (r >> 4) * 2 + (c >> 5), rr = r & 15, cc = c & 31, ob = rr * 64 + cc * 2; return st * 1024 + (ob ^ (((ob >> 9) & 1) << 5)); }
__host__ __device__ __forceinline__ void stage_rc(int b, int& R, int& C) { const int st = b / 1024, sb = b % 1024, swz = sb ^ (((sb >> 9) & 1) << 5); R = (st >> 1) * 16 + swz / 64; C = (st & 1) * 32 + (swz % 64) / 2; }
__host__ __device__ __forceinline__ int perm32(int rho) { const int n = rho >> 4, i = rho & 15; return 8 * (i >> 2) + 4 * n + (i & 3); }

struct Unit { int pm, pn; };
struct Gemm { const bf16_t* A; const bf16_t* Bt; int M, N, K; };

struct StaticOrder {
    int nM, nN, nwg, G, c;
    __host__ __device__ void init(int M, int N, int G_, int c_) { nM = M / BM; nN = N / BM; nwg = nM * nN; G = G_; c = c_; }
    __host__ __device__ bool next(int i, Unit& u) const {
        const long L = (long)i * G + c; if (L >= nwg) return false;
        int wgid = (int)L; { const int q = nwg / NXCD, r = nwg % NXCD, xcd = wgid % NXCD, off = wgid / NXCD; wgid = (xcd < r ? xcd * (q + 1) : r * (q + 1) + (xcd - r) * q) + off; }
        const int nig = WGM * nN, gid = wgid / nig, fm = gid * WGM, gsz = (nM - fm) < WGM ? (nM - fm) : WGM;
        u.pm = fm + ((wgid % nig) % gsz); u.pn = (wgid % nig) / gsz; return true;
    }
    __device__ __forceinline__ void a_ready(const Unit&) const {}
    __device__ __forceinline__ void done(const Unit&) const {}
};
__device__ __forceinline__ unsigned cvt_pk_bf16(float lo, float hi) { unsigned r; asm volatile("v_cvt_pk_bf16_f32 %0, %1, %2" : "=v"(r) : "v"(lo), "v"(hi)); return r; }
__device__ __forceinline__ float fast_exp(float x) { return __builtin_amdgcn_exp2f(x * 1.4426950408889634f); }
__device__ __forceinline__ float silu_f(float x) { return x * __builtin_amdgcn_rcpf(1.0f + fast_exp(-x)); }
__device__ __forceinline__ float sigmoid_f(float x) { return __builtin_amdgcn_rcpf(1.0f + fast_exp(-x)); }
__device__ __forceinline__ float gelu_tanh_f(float x) { const float z = 0.7978845608028654f * (x + 0.044715f * x * x * x); return x * __builtin_amdgcn_rcpf(1.0f + fast_exp(-2.0f * z)); }
typedef float f32x2 __attribute__((ext_vector_type(2)));
__device__ __forceinline__ f32x2 silu_mul_pk(f32x2 x, f32x2 u) {
    const f32x2 a = x * (-1.4426950408889634f);
    f32x2 e; e.x = __builtin_amdgcn_exp2f(a.x); e.y = __builtin_amdgcn_exp2f(a.y);
    const f32x2 d = e + 1.0f;
    f32x2 r; r.x = __builtin_amdgcn_rcpf(d.x); r.y = __builtin_amdgcn_rcpf(d.y);
    return (x * r) * u;
}
__device__ __forceinline__ f32x2 gelu_tanh_pk(f32x2 x) {
    const f32x2 x2 = x * x;
    const f32x2 a = x * (x2 * (-0.10294324f) + (-2.3022082f));
    f32x2 e; e.x = __builtin_amdgcn_exp2f(a.x); e.y = __builtin_amdgcn_exp2f(a.y);
    const f32x2 d = e + 1.0f;
    f32x2 r; r.x = __builtin_amdgcn_rcpf(d.x); r.y = __builtin_amdgcn_rcpf(d.y);
    return x * r;
}
__host__ __device__ __forceinline__ int kpos64(int l) { return (l & 32) | (((l >> 2) & 3) << 3) | ((l & 3) << 1) | ((l >> 4) & 1); }
__device__ __forceinline__ bf16_t bf16_1(float x) { return (bf16_t)(cvt_pk_bf16(x, x) & 0xffffu); }
typedef unsigned u32x2 __attribute__((ext_vector_type(2)));

struct EpiSwiglu {
    static constexpr bool PERM = true, AFTER_DRAIN = false;
    bf16_t* H; int ldh;
    __device__ __forceinline__ void operator()(const f32x4 (&acc)[2][2][4][2], const Unit& u, int wr, int wc, int fr, int fq) const {
        const int row0 = u.pm * BM + wr * 64 + fr; const int col0 = u.pn * HALF + wc * 32 + 8 * fq;
#pragma unroll
        for (int ai = 0; ai < 2; ++ai)
#pragma unroll
            for (int m = 0; m < 4; ++m) {
                bf16_t* p = H + (size_t)(row0 + ai * HALF + m * 16) * ldh + col0;
                const f32x4 g0 = acc[ai][0][m][0], g1 = acc[ai][0][m][1], u0 = acc[ai][1][m][0], u1 = acc[ai][1][m][1];
                u32x4 w;
                { const f32x2 a = silu_mul_pk((f32x2){g0[0], g0[1]}, (f32x2){u0[0], u0[1]}), b = silu_mul_pk((f32x2){g0[2], g0[3]}, (f32x2){u0[2], u0[3]});
                  const f32x2 c = silu_mul_pk((f32x2){g1[0], g1[1]}, (f32x2){u1[0], u1[1]}), d = silu_mul_pk((f32x2){g1[2], g1[3]}, (f32x2){u1[2], u1[3]});
                  w.x = cvt_pk_bf16(a.x, a.y); w.y = cvt_pk_bf16(b.x, b.y); w.z = cvt_pk_bf16(c.x, c.y); w.w = cvt_pk_bf16(d.x, d.y); }
                *(u32x4*)p = w;
            }
    }
};

struct EpiRes {
    static constexpr bool PERM = false, AFTER_DRAIN = false;
    int code;
    __device__ __forceinline__ void operator()(const f32x4 (&acc)[2][2][4][2], const Unit& u, int wr, int wc, int fr, int fq) const {
        typedef float f32x2e __attribute__((ext_vector_type(2)));
        typedef const float* cfp_t;
        const __attribute__((address_space(4))) cfp_t* ka = (const __attribute__((address_space(4))) cfp_t*)__builtin_amdgcn_kernarg_segment_ptr();
        const int kind = code >> 3, a = code & 7;
        float* out = (float*)ka[35]; const unsigned char* ws = (const unsigned char*)ka[36];
        const float* R; float* Y; float s; int lnq, strow0;
        if (kind == 2) { R = a == 0 ? ka[0] : (const float*)out; Y = out; s = 0.5f; lnq = a == 0 ? -1 : a == 1 ? 11 : a == 2 ? 15 : 29; strow0 = 0; }
        else if (kind == 6) { Y = out + (size_t)a * 16384 * 1024; R = Y; s = 1.0f; lnq = 3; strow0 = a * 16384; }
        else { R = out; Y = out; s = 1.0f; lnq = 19; strow0 = 0; }
        const float alpha = 1.4142135623730951f;
        const bool use_ln = lnq >= 0;
        const float* st = (const float*)(ws + (5u * 1048576u + 524288u));
        const float* lg = ka[use_ln ? lnq : 3]; const float* lb = ka[use_ln ? lnq + 1 : 4];
        const int row0 = u.pm * BM + wr * 64 + fr; const int col0 = u.pn * BM + wc * 32 + 4 * fq;
#pragma unroll
        for (int ai = 0; ai < 2; ++ai)
#pragma unroll
            for (int m = 0; m < 4; ++m) {
                const int row = row0 + ai * HALF + m * 16;
                f32x2e ms = (f32x2e){0.f, 1.f};
                if (use_ln) ms = *(const f32x2e*)(st + (size_t)(strow0 + row) * 2);
#pragma unroll
                for (int bj = 0; bj < 2; ++bj)
#pragma unroll
                    for (int n = 0; n < 2; ++n) {
                        const int col = col0 + bj * HALF + n * 16;
                        const size_t off = (size_t)row * 1024 + col;
                        f32x4 r = *(const f32x4*)(R + off);
                        if (use_ln) { const f32x4 gv = *(const f32x4*)(lg + col), bv = *(const f32x4*)(lb + col); r = (r - ms.x) * ms.y * gv + bv; }
                        *(f32x4*)(Y + off) = r * alpha + acc[ai][bj][m][n] * s;
                    }
                asm volatile("" ::: "memory");
            }
    }
};

struct EpiGm {
    static constexpr bool PERM = false, AFTER_DRAIN = false;
    bf16_t* U; bf16_t* VT; float* PS;
    __device__ __forceinline__ void operator()(const f32x4 (&acc)[2][2][4][2], const Unit& u, int wr, int wc, int fr, int fq) const {
        const int row0 = u.pm * BM + wr * 64 + fr;
        if (u.pn < 12) {
            const int col0 = u.pn * BM + wc * 32 + 4 * fq;
#pragma unroll
            for (int ai = 0; ai < 2; ++ai)
#pragma unroll
                for (int m = 0; m < 4; ++m)
#pragma unroll
                    for (int bj = 0; bj < 2; ++bj)
#pragma unroll
                        for (int n = 0; n < 2; ++n) {
                            const f32x4 v = acc[ai][bj][m][n];
                            const f32x2 ga = gelu_tanh_pk((f32x2){v[0], v[1]}), gb = gelu_tanh_pk((f32x2){v[2], v[3]});
                            u32x2 w; w.x = cvt_pk_bf16(ga.x, ga.y); w.y = cvt_pk_bf16(gb.x, gb.y);
                            *(u32x2*)(U + (size_t)(row0 + ai * HALF + m * 16) * 3072 + col0 + bj * HALF + n * 16) = w;
                            if (bj == 1 && n == 1) asm volatile("" ::: "memory");
                        }
        } else {
            const int col0 = (u.pn - 12) * BM + wc * 32 + 4 * fq;
#pragma unroll
            for (int ai = 0; ai < 2; ++ai)
#pragma unroll
                for (int m = 0; m < 4; ++m) {
                    const int row = row0 + ai * HALF + m * 16; const int ch = row >> 7, s = row & 127;
                    bf16_t* base = VT + (size_t)ch * 3072 * 128 + s;
                    float ssum = 0.f, qsum = 0.f;
#pragma unroll
                    for (int bj = 0; bj < 2; ++bj)
#pragma unroll
                        for (int n = 0; n < 2; ++n) {
                            const f32x4 v = acc[ai][bj][m][n]; const int c = col0 + bj * HALF + n * 16;
                            const f32x2 ga = gelu_tanh_pk((f32x2){v[0], v[1]}), gb = gelu_tanh_pk((f32x2){v[2], v[3]}); const float gq[4] = {ga.x, ga.y, gb.x, gb.y};
#pragma unroll
                            for (int i = 0; i < 4; ++i) { const float gv = gq[i]; ssum += gv; qsum += gv * gv; base[(size_t)(c + i) * 128] = bf16_1(gv); }
                            asm volatile("" ::: "memory");
                        }
                    ssum += __shfl_xor(ssum, 16); ssum += __shfl_xor(ssum, 32); qsum += __shfl_xor(qsum, 16); qsum += __shfl_xor(qsum, 32);
                    if (fq == 0) { f32x2 pq; pq.x = ssum; pq.y = qsum; *(f32x2*)(PS + ((size_t)row * 48 + (u.pn - 12) * 4 + wc) * 2) = pq; }
                }
        }
    }
};

struct EpiNsa {
    static constexpr bool PERM = false, AFTER_DRAIN = false;
    bf16_t *Qr, *KC, *VC, *KS, *VST, *KW, *VWT; float* Gt; const float* cosT; const float* sinT;
    __device__ __forceinline__ void operator()(const f32x4 (&acc)[2][2][4][2], const Unit& u, int wr, int wc, int fr, int fq) const {
        const int row0 = u.pm * BM + wr * 64 + fr; const int pn = u.pn;
#pragma unroll
        for (int ai = 0; ai < 2; ++ai)
#pragma unroll
            for (int m = 0; m < 4; ++m) {
                const int row = row0 + ai * HALF + m * 16; const int b = row >> 14, t = row & 16383;
                if (pn < 6) {
#pragma unroll
                    for (int n = 0; n < 2; ++n) {
                        const int dl = 16 * n + 4 * fq;
                        const f32x4 cs = *(const f32x4*)(cosT + (size_t)t * 32 + dl), sn = *(const f32x4*)(sinT + (size_t)t * 32 + dl);
                        const f32x4 x1 = acc[ai][0][m][n], x2 = acc[ai][1][m][n];
                        f32x4 y1 = x1 * cs - x2 * sn, y2 = x2 * cs + x1 * sn;
                        bf16_t* dst;
                        if (pn < 4) { y1 = y1 * 0.18033688011112042f; y2 = y2 * 0.18033688011112042f;     dst = Qr + (size_t)row * 1024 + (4 * pn + wc) * 64 + dl; }
                        else { dst = (pn == 4 ? KS : KW) + ((size_t)(b * 4 + wc) * 16384 + t) * 64 + dl; }
                        u32x2 w1, w2; w1.x = cvt_pk_bf16(y1[0], y1[1]); w1.y = cvt_pk_bf16(y1[2], y1[3]); w2.x = cvt_pk_bf16(y2[0], y2[1]); w2.y = cvt_pk_bf16(y2[2], y2[3]);
                        *(u32x2*)dst = w1; *(u32x2*)(dst + 32) = w2;
                    }
                } else if (pn < 8) {
                    bf16_t* base = (pn == 6 ? KC : VC) + (size_t)row * 256 + wc * 32 + 4 * fq;
#pragma unroll
                    for (int bj = 0; bj < 2; ++bj)
#pragma unroll
                        for (int n = 0; n < 2; ++n) { const f32x4 v = acc[ai][bj][m][n]; u32x2 w; w.x = cvt_pk_bf16(v[0], v[1]); w.y = cvt_pk_bf16(v[2], v[3]); *(u32x2*)(base + bj * HALF + n * 16) = w; }
                } else if (pn < 10) {
                    bf16_t* base = (pn == 8 ? VST : VWT);
#pragma unroll
                    for (int bj = 0; bj < 2; ++bj)
#pragma unroll
                        for (int n = 0; n < 2; ++n) {
                            const f32x4 v = acc[ai][bj][m][n]; const int col = bj * HALF + wc * 32 + n * 16 + 4 * fq;
                            const int g = col >> 6, d = col & 63;
                            bf16_t* p = base + ((((size_t)(b * 4 + g)) * 256 + (t >> 6)) * 64 + d) * 64 + kpos64(t & 63);
#pragma unroll
                            for (int i = 0; i < 4; ++i) p[i * 64] = bf16_1(v[i]);
                        }
                } else {
#pragma unroll
                    for (int n = 0; n < 2; ++n) {
                        const f32x4 v = acc[ai][0][m][n]; const int col = wc * 32 + n * 16 + 4 * fq;
                        if (col < 48) { f32x4 o; o[0] = sigmoid_f(v[0]); o[1] = sigmoid_f(v[1]); o[2] = sigmoid_f(v[2]); o[3] = sigmoid_f(v[3]); *(f32x4*)(Gt + (size_t)row * 48 + col) = o; }
                    }
                }
                asm volatile("" ::: "memory");
            }
    }
};
template <class Epi, class Sched, bool ALIGN_EPI = false, bool SP2 = false>
__device__ __forceinline__ void gemm_phase(PG8_LAS unsigned char* lds, const Gemm g, const Sched& S, const Epi& E) {
    int tid_l = threadIdx.x; asm volatile("" : "+v"(tid_l));
    const int tid = tid_l, wid = __builtin_amdgcn_readfirstlane(tid >> 6), lane = tid & 63, wr = wid >> 2, wc = wid & 3, fr = lane & 15, fq = lane >> 4;
    const int K = g.K, nt = K / BK;
    unsigned voffA[2], voffB[2];
#pragma unroll
    for (int i = 0; i < 2; ++i) { int R, C; stage_rc(tid * 16 + i * 8192, R, C); const int Rb = Epi::PERM ? ((R & ~31) + perm32(R & 31)) : R;
        voffA[i] = (unsigned)(R * K + C) * 2u; voffB[i] = (unsigned)(Rb * K + C) * 2u; }
    const size_t kstep = (size_t)(BK * 2);
    const size_t hstep = (size_t)HALF * K * 2;
    const size_t tstep = 2 * hstep;
    const unsigned ldsw = (unsigned)wid * 1024u;
    const int aoff = lds_byte(wr * 64 + fr, fq * 8), boff = lds_byte(wc * 32 + fr, fq * 8);
#define PG8_SA(b, h) (((b) * 2 + (h)) * HTB)
#define PG8_SB(b, h) ((4 + (b) * 2 + (h)) * HTB)
#define PG8_STAGE(bufoff, gbase, voff) do { _Pragma("unroll") for (int _i = 0; _i < 2; ++_i) \
        __builtin_amdgcn_global_load_lds((const unsigned*)((const char*)(gbase) + (voff)[_i]), (PG8_LAS unsigned*)(lds + (bufoff) + ldsw + _i * 8192), 16, 0, 0); } while (0)
#define PG8_LDA(dst, b, h) do { _Pragma("unroll") for (int m = 0; m < 4; ++m) _Pragma("unroll") for (int k = 0; k < 2; ++k) dst[m][k] = *(const PG8_LAS bf16x8*)(lds + PG8_SA(b, h) + aoff + m * 2048 + k * 1024); } while (0)
#define PG8_LDB(dst, b, h) do { _Pragma("unroll") for (int n = 0; n < 2; ++n) _Pragma("unroll") for (int k = 0; k < 2; ++k) dst[n][k] = *(const PG8_LAS bf16x8*)(lds + PG8_SB(b, h) + boff + n * 2048 + k * 1024); } while (0)
#define PG8_MMA(ai, bj, At, Bt) do { __builtin_amdgcn_s_setprio(1); _Pragma("unroll") for (int m = 0; m < 4; ++m) _Pragma("unroll") for (int n = 0; n < 2; ++n) _Pragma("unroll") for (int k = 0; k < 2; ++k) \
        acc[ai][bj][m][n] = __builtin_amdgcn_mfma_f32_16x16x32_bf16(Bt[n][k], At[m][k], acc[ai][bj][m][n], 0, 0, 0); __builtin_amdgcn_s_setprio(0); } while (0)
#define PG8_WAIT_V(n) asm volatile("s_waitcnt vmcnt(" #n ")" ::: "memory")
#define PG8_WAIT_L(n) asm volatile("s_waitcnt lgkmcnt(" #n ")" ::: "memory")
#define PG8_BAR __builtin_amdgcn_s_barrier()
#define PG8_SCHED __builtin_amdgcn_sched_barrier(0)
    Unit cur, nxt; int ui = 0;
    if (!S.next(0, cur)) return;
    f32x4 acc[2][2][4][2];
#pragma unroll
    for (int a = 0; a < 2; ++a)
#pragma unroll
        for (int b = 0; b < 2; ++b)
#pragma unroll
            for (int m = 0; m < 4; ++m)
#pragma unroll
                for (int n = 0; n < 2; ++n) acc[a][b][m][n] = (f32x4){0.f, 0.f, 0.f, 0.f};
    bf16x8 At[4][2], B0[2][2], B1[2][2];
    const char* cA = (const char*)g.A + (size_t)cur.pm * tstep; const char* cB = (const char*)g.Bt + (size_t)cur.pn * tstep;
    S.a_ready(cur);
    if constexpr (SP2) {
        PG8_STAGE(PG8_SB(0, 0), cB, voffB); PG8_STAGE(PG8_SB(0, 1), cB + hstep, voffB); PG8_STAGE(PG8_SA(0, 0), cA, voffA); PG8_STAGE(PG8_SA(0, 1), cA + hstep, voffA);
        if (wr == 1) PG8_BAR;
        PG8_WAIT_V(2); PG8_BAR;
        PG8_STAGE(PG8_SB(1, 0), cB + kstep, voffB); PG8_STAGE(PG8_SA(1, 0), cA + kstep, voffA); PG8_STAGE(PG8_SB(1, 1), cB + hstep + kstep, voffB);
        PG8_WAIT_V(6); PG8_BAR;
    } else {
        PG8_STAGE(PG8_SB(0, 0), cB, voffB); PG8_STAGE(PG8_SA(0, 0), cA, voffA); PG8_STAGE(PG8_SB(0, 1), cB + hstep, voffB); PG8_STAGE(PG8_SA(0, 1), cA + hstep, voffA);
        if (wr == 1) PG8_BAR;
        PG8_WAIT_V(4); PG8_BAR;
        PG8_STAGE(PG8_SB(1, 0), cB + kstep, voffB); PG8_STAGE(PG8_SA(1, 0), cA + kstep, voffA); PG8_STAGE(PG8_SB(1, 1), cB + hstep + kstep, voffB);
        PG8_WAIT_V(6); PG8_BAR;
    }
    for (;;) {
        const bool has_next = S.next(ui + 1, nxt);
        const char* nA = has_next ? (const char*)g.A + (size_t)nxt.pm * tstep : cA; const char* nB = has_next ? (const char*)g.Bt + (size_t)nxt.pn * tstep : cB;
        for (int t = 0; t < nt; t += 2) {
            const bool last = (t == nt - 2);
            const char* a1 = cA + (size_t)(t + 1) * kstep;
            const char* a2 = last ? nA : cA + (size_t)(t + 2) * kstep; const char* b2 = last ? nB : cB + (size_t)(t + 2) * kstep;
            const char* a3 = a2 + kstep; const char* b3 = b2 + kstep;
            if (last && has_next) S.a_ready(nxt);
            if constexpr (SP2) {
            PG8_LDB(B0, 0, 0); PG8_LDB(B1, 0, 1); PG8_SCHED; PG8_LDA(At, 0, 0); PG8_STAGE(PG8_SA(1, 1), a1 + hstep, voffA);
            PG8_WAIT_V(8); PG8_WAIT_L(0); PG8_BAR; PG8_MMA(0, 0, At, B0); PG8_MMA(0, 1, At, B1); PG8_BAR; PG8_SCHED;
            PG8_LDA(At, 0, 1); PG8_STAGE(PG8_SB(0, 0), b2, voffB); PG8_STAGE(PG8_SB(0, 1), b2 + hstep, voffB); PG8_STAGE(PG8_SA(0, 0), a2, voffA);
            PG8_WAIT_V(8); PG8_WAIT_L(0); PG8_BAR; PG8_MMA(1, 0, At, B0); PG8_MMA(1, 1, At, B1); PG8_BAR; PG8_SCHED;
            PG8_LDB(B0, 1, 0); PG8_LDB(B1, 1, 1); PG8_SCHED; PG8_LDA(At, 1, 0); PG8_STAGE(PG8_SA(0, 1), a2 + hstep, voffA);
            PG8_WAIT_V(8); PG8_WAIT_L(0); PG8_BAR; PG8_MMA(0, 0, At, B0); PG8_MMA(0, 1, At, B1); PG8_BAR; PG8_SCHED;
            PG8_LDA(At, 1, 1); PG8_STAGE(PG8_SB(1, 0), b3, voffB); PG8_STAGE(PG8_SB(1, 1), b3 + hstep, voffB); PG8_STAGE(PG8_SA(1, 0), a3, voffA);
            PG8_WAIT_V(8); PG8_WAIT_L(0); PG8_BAR; PG8_MMA(1, 0, At, B0); PG8_MMA(1, 1, At, B1); PG8_BAR; PG8_SCHED;
            } else {
            PG8_LDB(B0, 0, 0); PG8_SCHED; PG8_LDA(At, 0, 0); PG8_STAGE(PG8_SA(1, 1), a1 + hstep, voffA);
            PG8_WAIT_L(8); PG8_BAR; PG8_WAIT_L(0); PG8_MMA(0, 0, At, B0); PG8_BAR; PG8_SCHED;
            PG8_LDB(B1, 0, 1); PG8_STAGE(PG8_SB(0, 0), b2, voffB);
            PG8_BAR; PG8_WAIT_L(0); PG8_MMA(0, 1, At, B1); PG8_BAR;
            PG8_LDA(At, 0, 1); PG8_STAGE(PG8_SA(0, 0), a2, voffA);
            PG8_BAR; PG8_WAIT_L(0); PG8_MMA(1, 0, At, B0); PG8_BAR; PG8_SCHED;
            PG8_STAGE(PG8_SB(0, 1), b2 + hstep, voffB);
            PG8_WAIT_V(6); PG8_BAR; PG8_MMA(1, 1, At, B1); PG8_BAR;
            PG8_LDB(B0, 1, 0); PG8_SCHED; PG8_LDA(At, 1, 0); PG8_STAGE(PG8_SA(0, 1), a2 + hstep, voffA);
            PG8_WAIT_L(8); PG8_BAR; PG8_WAIT_L(0); PG8_MMA(0, 0, At, B0); PG8_BAR; PG8_SCHED;
            PG8_LDB(B1, 1, 1); PG8_STAGE(PG8_SB(1, 0), b3, voffB);
            PG8_BAR; PG8_WAIT_L(0); PG8_MMA(0, 1, At, B1); PG8_BAR;
            PG8_LDA(At, 1, 1); PG8_STAGE(PG8_SA(1, 0), a3, voffA);
            PG8_BAR; PG8_WAIT_L(0); PG8_MMA(1, 0, At, B0); PG8_BAR; PG8_SCHED;
            PG8_STAGE(PG8_SB(1, 1), b3 + hstep, voffB);
            PG8_WAIT_V(6); PG8_BAR; PG8_MMA(1, 1, At, B1); PG8_BAR;
            }
        }
        if constexpr (ALIGN_EPI) { if (wr == 0) PG8_BAR; }
        if constexpr (!Epi::AFTER_DRAIN) { E(acc, cur, wr, wc, fr, fq); S.done(cur); }
        if (!has_next) break;
#pragma unroll
        for (int a = 0; a < 2; ++a)
#pragma unroll
            for (int b = 0; b < 2; ++b)
#pragma unroll
                for (int m = 0; m < 4; ++m)
#pragma unroll
                    for (int n = 0; n < 2; ++n) acc[a][b][m][n] = (f32x4){0.f, 0.f, 0.f, 0.f};
        cur = nxt; cA = nA; cB = nB; ++ui;
        if constexpr (ALIGN_EPI) { if (wr == 1) PG8_BAR; }
    }
    PG8_WAIT_V(0);
    if constexpr (!ALIGN_EPI) { if (wr == 0) PG8_BAR; }
    PG8_BAR;
    if constexpr (Epi::AFTER_DRAIN) { E.fused(acc, cur, wr, wc, fr, fq, lds, wid, lane); S.done(cur); }
#undef PG8_SA
#undef PG8_SB
#undef PG8_STAGE
#undef PG8_LDA
#undef PG8_LDB
#undef PG8_MMA
#undef PG8_WAIT_V
#undef PG8_WAIT_L
#undef PG8_BAR
#undef PG8_SCHED
}
}
#include <hip/hip_cooperative_groups.h>
namespace cg = cooperative_groups;
#ifndef REP_ATTN
#define REP_ATTN 1
#endif
#ifndef REP_SYNC
#define REP_SYNC 1
#endif
#ifndef OLD_SEL
#define OLD_SEL 1
#endif
#ifndef REP_LN
#define REP_LN 1
#endif
#ifndef REP_NSI
#define REP_NSI 1
#endif
#ifndef REP_UP
#define REP_UP 1
#endif
#ifndef REP_GMI
#define REP_GMI 1
#endif
#ifndef REP_PRO
#define REP_PRO 1
#endif
#ifndef REP_GATE
#define REP_GATE 1
#endif
#ifndef REP_CMPR
#define REP_CMPR 1
#endif
#ifndef REP_CMP
#define REP_CMP 1
#endif
#ifndef REP_TOPK
#define REP_TOPK 1
#endif
#ifndef REP_SEL
#define REP_SEL 1
#endif
#ifndef REP_WIN
#define REP_WIN 1
#endif
typedef unsigned short bf16;
typedef float f32x4 __attribute__((ext_vector_type(4)));
typedef short bf16x8 __attribute__((ext_vector_type(8)));
typedef unsigned u32x4 __attribute__((ext_vector_type(4)));
typedef unsigned u32x2 __attribute__((ext_vector_type(2)));

constexpr int SEQ = 16384, MTOK = 32768, DM = 1024, DFF = 2816, GMW = 3072;
constexpr float ALPHA = 1.4142135623730951f;
constexpr float LN_EPS = 1e-5f;
constexpr size_t MiB = 1u << 20;
constexpr size_t WS_COS = 1 * MiB, WS_SIN = 3 * MiB, WS_CB = 5 * MiB;
constexpr size_t WS_ST = 5 * MiB + 512 * 1024;
constexpr size_t WS_W = 6 * MiB;
constexpr size_t W_FFN_STRIDE = 16 * MiB + MiB / 2;
constexpr size_t W_FFN_W2 = 11 * MiB;
constexpr size_t WS_GMI = WS_W + 66 * MiB, WS_GMO = WS_GMI + 12 * MiB, WS_NSI = WS_GMO + 6 * MiB, WS_NSO = WS_NSI + 5 * MiB + MiB / 2;
constexpr size_t WS_W1K = WS_NSO + 2 * MiB, WS_W1V = WS_W1K + 1 * MiB, WS_W2K = WS_W1V + 1 * MiB, WS_W2V = WS_W2K + MiB / 2;
constexpr size_t WS_XB = 102 * MiB, WS_R1 = 166 * MiB, WS_R2 = 358 * MiB, WS_PS = 454 * MiB, WS_END = 462 * MiB;
static_assert(WS_W2V + MiB / 2 <= WS_XB, "weights fit");
constexpr size_t R1_H = WS_R1;
constexpr size_t R1_U = WS_R1, R1_VT = WS_R1 + 96 * MiB;
constexpr size_t R1_Q = WS_R1, R1_KC = R1_Q + 64 * MiB, R1_VC = R1_KC + 16 * MiB, R1_KS = R1_VC + 16 * MiB, R1_VST = R1_KS + 16 * MiB,
                 R1_KW = R1_VST + 16 * MiB, R1_VWT = R1_KW + 16 * MiB, R1_GT = R1_VWT + 16 * MiB, R1_KCMP = R1_GT + 6 * MiB, R1_VCMPT = R1_KCMP + 1 * MiB;
static_assert(R1_VCMPT + 1 * MiB <= WS_R2, "R1 overlay");
constexpr int LDS_BYTES = 157696;
#define XCD_BAR_WORDS 3456

#define LAS __attribute__((address_space(3)))
#define GAS __attribute__((address_space(1)))
struct Params { const float* in[35]; float* out; unsigned char* ws; };
typedef const float* cfptr;
__device__ __forceinline__ const float* kin(int i) {
    const __attribute__((address_space(4))) cfptr* ka = (const __attribute__((address_space(4))) cfptr*)__builtin_amdgcn_kernarg_segment_ptr();
    return ka[i];
}

__device__ __forceinline__ unsigned f2bf(float f) { unsigned u = __builtin_bit_cast(unsigned, f); return (u + 0x7fffu + ((u >> 16) & 1u)) >> 16; }
__device__ __forceinline__ unsigned pk2(float lo, float hi) { return pg8::cvt_pk_bf16(lo, hi); }
__device__ __forceinline__ float bf2f(unsigned b) { return __builtin_bit_cast(float, b << 16); }
__device__ __forceinline__ float wave_sum(float v) {
#pragma unroll
    for (int o = 1; o < 64; o <<= 1) v += __shfl_xor(v, o);
    return v;
}
__device__ __forceinline__ unsigned char* launder_ptr(unsigned char* p) {
    const unsigned long long v = (unsigned long long)p; unsigned lo = (unsigned)v, hi = (unsigned)(v >> 32); asm volatile("" : "+v"(lo), "+v"(hi));
    lo = __builtin_amdgcn_readfirstlane(lo); hi = __builtin_amdgcn_readfirstlane(hi); return (unsigned char*)(((unsigned long long)hi << 32) | lo);
}
__device__ __forceinline__ f32x4 mfma16(bf16x8 a, bf16x8 b, f32x4 c) { return __builtin_amdgcn_mfma_f32_16x16x32_bf16(a, b, c, 0, 0, 0); }
using pg8::fast_exp;

__device__ __forceinline__ int srccol(int mode, int r) {
    if (mode == 0) return r;
    if (mode == 1) { const int pn = r >> 8, j = r & 255; return j < 128 ? 128 * pn + j : 2816 + 128 * pn + (j - 128); }
    const int tile = r >> 8, j = r & 255, half = j >> 7, jj = j & 127;
    if (tile < 4) return (4 * tile + (jj >> 5)) * 64 + (jj & 31) + 32 * half;
    if (tile == 4) return 1536 + (jj >> 5) * 64 + (jj & 31) + 32 * half;
    if (tile == 5) return 2048 + (jj >> 5) * 64 + (jj & 31) + 32 * half;
    if (tile == 6) return 1024 + j;
    if (tile == 7) return 1280 + j;
    if (tile == 8) return 1792 + j;
    if (tile == 9) return 2304 + j;
    return j < 48 ? 2560 + j : -1;
}
struct TItem { const GAS float* W; GAS bf16* WT; int K, Nsrc, mode, k0, n0; };
__device__ __forceinline__ void titem_load(const TItem& t, f32x4 (&v)[8], int lane) {
    const int c4 = lane & 7, kr = lane >> 3;
    const int sc = srccol(t.mode, t.n0 + 4 * c4);
#pragma unroll
    for (int i = 0; i < 8; ++i) { const int kk = kr + 8 * i;
        v[i] = sc >= 0 ? *(const GAS f32x4*)(t.W + (size_t)(t.k0 + kk) * t.Nsrc + sc) : (f32x4){0.f, 0.f, 0.f, 0.f}; }
}
__device__ __forceinline__ void titem_finish(const TItem& t, const f32x4 (&v)[8], LAS float* scr, int lane) {
    const int c4 = lane & 7, kr = lane >> 3;
#pragma unroll
    for (int i = 0; i < 8; ++i) { const int kk = kr + 8 * i; LAS float* d = scr + kk * 33 + 4 * c4; d[0] = v[i][0]; d[1] = v[i][1]; d[2] = v[i][2]; d[3] = v[i][3]; }
    asm volatile("s_waitcnt lgkmcnt(0)" ::: "memory");
    const int c = lane & 7;
#pragma unroll
    for (int j = 0; j < 4; ++j) { const int n = (lane >> 3) + 8 * j; const LAS float* s = scr + (8 * c) * 33 + n;
        u32x4 o; o.x = pk2(s[0 * 33], s[1 * 33]); o.y = pk2(s[2 * 33], s[3 * 33]); o.z = pk2(s[4 * 33], s[5 * 33]); o.w = pk2(s[6 * 33], s[7 * 33]);
        *(GAS u32x4*)(t.WT + (size_t)(t.n0 + n) * t.K + t.k0 + 8 * c) = o; }
    asm volatile("s_waitcnt lgkmcnt(0)" ::: "memory");
}
__device__ __forceinline__ void sincos_d(double rd, float& c, float& s) {
    const float r = (float)rd, r2 = r * r;
    float sv = -1.9572941e-20f;
    sv = sv * r2 + 8.2206352e-18f;
    sv = sv * r2 - 2.8114573e-15f;
    sv = sv * r2 + 7.6471637e-13f;
    sv = sv * r2 - 1.6059044e-10f;
    sv = sv * r2 + 2.5052108e-08f;
    sv = sv * r2 - 2.7557319e-06f;
    sv = sv * r2 + 1.9841270e-04f;
    sv = sv * r2 - 8.3333333e-03f;
    sv = sv * r2 + 1.6666667e-01f;
    sv = r - r * r2 * sv;
    float cv = 4.1103176e-19f;
    cv = cv * r2 - 1.5619207e-16f;
    cv = cv * r2 + 4.7794773e-14f;
    cv = cv * r2 - 1.1470746e-11f;
    cv = cv * r2 + 2.0876757e-09f;
    cv = cv * r2 - 2.7557319e-07f;
    cv = cv * r2 + 2.4801587e-05f;
    cv = cv * r2 - 1.3888889e-03f;
    cv = cv * r2 + 4.1666667e-02f;
    cv = cv * r2 - 0.5f;
    cv = cv * r2 + 1.0f;
    c = cv; s = sv;
}

__device__ __forceinline__ void prologue(const Params& p, unsigned char* lds, int tid, int lane, int wave) {
    unsigned char* ws = launder_ptr(p.ws);
    LAS float* scr = (LAS float*)((LAS unsigned char*)lds + wave * 16384);
    const int gw = blockIdx.x * 8 + wave, NGW = gridDim.x * 8;
    {
        constexpr int NI_IN = 16 * 176, NI_OUT = 44 * 32, NI_FFN = NI_IN + NI_OUT;
        constexpr int O_GMI = 4 * NI_FFN, O_GMO = O_GMI + 16 * 192, O_NSI = O_GMO + 48 * 32, O_NSO = O_NSI + 16 * 88, O_W1K = O_NSO + 16 * 32,
                      O_W1V = O_W1K + 32 * 8, O_W2K = O_W1V + 32 * 8, O_W2V = O_W2K + 4 * 2, NTOT = O_W2V + 4 * 2;
        auto decode = [&](int gi) -> TItem {
            TItem t; int it, Ndst;
            if (gi < O_GMI) { const int f = gi / NI_FFN, r = gi - f * NI_FFN; const int base = (f == 0 ? 1 : f == 1 ? 13 : f == 2 ? 17 : 31);
                if (r < NI_IN) { it = r; t.W = (const GAS float*)kin(base); t.K = 1024; t.Nsrc = 5632; Ndst = 5632; t.mode = 1; t.WT = (GAS bf16*)(ws + WS_W + f * W_FFN_STRIDE); }
                else { it = r - NI_IN; t.W = (const GAS float*)kin(base + 1); t.K = 2816; t.Nsrc = 1024; Ndst = 1024; t.mode = 0; t.WT = (GAS bf16*)(ws + WS_W + f * W_FFN_STRIDE + W_FFN_W2); } }
            else if (gi < O_GMO) { it = gi - O_GMI; t.W = (const GAS float*)kin(5);  t.K = 1024; t.Nsrc = 6144; Ndst = 6144; t.mode = 0; t.WT = (GAS bf16*)(ws + WS_GMI); }
            else if (gi < O_NSI) { it = gi - O_GMO; t.W = (const GAS float*)kin(10); t.K = 3072; t.Nsrc = 1024; Ndst = 1024; t.mode = 0; t.WT = (GAS bf16*)(ws + WS_GMO); }
            else if (gi < O_NSO) { it = gi - O_NSI; t.W = (const GAS float*)kin(21); t.K = 1024; t.Nsrc = 2608; Ndst = 2816; t.mode = 2; t.WT = (GAS bf16*)(ws + WS_NSI); }
            else if (gi < O_W1K) { it = gi - O_NSO; t.W = (const GAS float*)kin(28); t.K = 1024; t.Nsrc = 1024; Ndst = 1024; t.mode = 0; t.WT = (GAS bf16*)(ws + WS_NSO); }
            else if (gi < O_W1V) { it = gi - O_W1K; t.W = (const GAS float*)kin(23); t.K = 2048; t.Nsrc = 256;  Ndst = 256;  t.mode = 0; t.WT = (GAS bf16*)(ws + WS_W1K); }
            else if (gi < O_W2K) { it = gi - O_W1V; t.W = (const GAS float*)kin(26); t.K = 2048; t.Nsrc = 256;  Ndst = 256;  t.mode = 0; t.WT = (GAS bf16*)(ws + WS_W1V); }
            else if (gi < O_W2V) { it = gi - O_W2K; t.W = (const GAS float*)kin(24); t.K = 256;  t.Nsrc = 64;   Ndst = 64;   t.mode = 0; t.WT = (GAS bf16*)(ws + WS_W2K); }
            else                 { it = gi - O_W2V; t.W = (const GAS float*)kin(27); t.K = 256;  t.Nsrc = 64;   Ndst = 64;   t.mode = 0; t.WT = (GAS bf16*)(ws + WS_W2V); }
            const int nblk = Ndst / 32; t.k0 = 64 * (it / nblk); t.n0 = 32 * (it % nblk);
            return t;
        };
        if (gw < NTOT) {
            TItem cur = decode(gw); f32x4 vc[8]; titem_load(cur, vc, lane);
            for (int gi = gw; gi < NTOT; gi += NGW) {
                const bool more = gi + NGW < NTOT;
                TItem nxt = cur; f32x4 vn[8];
#pragma unroll
                for (int i = 0; i < 8; ++i) vn[i] = vc[i];
                if (more) { nxt = decode(gi + NGW); titem_load(nxt, vn, lane); }
                titem_finish(cur, vc, scr, lane);
                cur = nxt;
#pragma unroll
                for (int i = 0; i < 8; ++i) vc[i] = vn[i];
            }
        }
    }
    {
        const GAS f32x4* x4 = (const GAS f32x4*)kin(0); GAS u32x4* xb = (GAS u32x4*)(ws + WS_XB);
        const size_t n8 = (size_t)MTOK * DM / 8;
        for (size_t i = (size_t)blockIdx.x * 512 + tid; i < n8; i += (size_t)gridDim.x * 512) {
            const f32x4 a = x4[2 * i], b = x4[2 * i + 1];
            u32x4 o; o.x = pk2(a[0], a[1]); o.y = pk2(a[2], a[3]); o.z = pk2(b[0], b[1]); o.w = pk2(b[2], b[3]); xb[i] = o;
        }
    }
    {
        GAS float* cosT = (GAS float*)(ws + WS_COS); GAS float* sinT = (GAS float*)(ws + WS_SIN);
        for (int idx = blockIdx.x * 512 + tid; idx < SEQ * 32; idx += gridDim.x * 512) {
            const int pos = idx >> 5, i = idx & 31;
            double f = 1.0; const double r = 0.74989420933245582730;
            for (int k = 0; k < i; ++k) f *= r;
            const double ang = (double)pos * f;
            const double TWO_PI_HI = 6.283185307179586232, TWO_PI_LO = 2.4492935982947064e-16;
            const double kq = __builtin_rint(ang * 0.15915494309189533577);
            double rr = ang - kq * TWO_PI_HI; rr = rr - kq * TWO_PI_LO;
            float c, s; sincos_d(rr, c, s);
            cosT[idx] = c; sinT[idx] = s;
        }
    }
    if (blockIdx.x == 0 && tid == 0) *(GAS unsigned*)ws = 0u;
    if (blockIdx.x == 0) { GAS unsigned* bw = (GAS unsigned*)(ws + 16384); for (int i = tid; i < XCD_BAR_WORDS; i += 512) bw[i] = 0u; }
    {
        LAS float* rb = (LAS float*)lds;
        for (int c = blockIdx.x; c < 256; c += gridDim.x) {
            __syncthreads();
#pragma unroll
            for (int e = 0; e < 2; ++e) {
                const int oi = 2 * c + e, kv = oi >> 8, h = oi & 255;
                const GAS float* pe = (const GAS float*)kin(kv ? 25 : 22); const GAS float* w1 = (const GAS float*)kin(kv ? 26 : 23);
                float a = 0.f;
#pragma unroll
                for (int kk = 0; kk < 4; ++kk) { const int kx = tid + 512 * kk; a += pe[kx] * w1[(size_t)kx * 256 + h]; }
                rb[e * 512 + tid] = a;
            }
            __syncthreads();
            for (int sft = 256; sft > 0; sft >>= 1) {
                if (tid < sft) { rb[tid] += rb[tid + sft]; rb[512 + tid] += rb[512 + tid + sft]; }
                __syncthreads();
            }
            if (tid < 2) ((GAS float*)(ws + WS_CB))[2 * c + tid] = rb[tid * 512];
        }
    }
}

template <int FINAL>
__device__ __forceinline__ void ln_phase(const GAS float* Y, GAS float* X, GAS bf16* XB, GAS float* ST, const GAS float* g, const GAS float* b, int lane, int wave) {
    typedef float f32x2e __attribute__((ext_vector_type(2)));
    const int gw = blockIdx.x * 8 + wave, NGW = gridDim.x * 8;
    f32x4 gv[4], bv[4];
#pragma unroll
    for (int j = 0; j < 4; ++j) { gv[j] = ((const GAS f32x4*)g)[lane + 64 * j]; bv[j] = ((const GAS f32x4*)b)[lane + 64 * j]; }
    f32x4 vn[4];
    { const GAS f32x4* xr = (const GAS f32x4*)(Y + (size_t)(gw < MTOK ? gw : 0) * DM) + lane;
#pragma unroll
      for (int j = 0; j < 4; ++j) vn[j] = xr[64 * j]; }
    for (int m = gw; m < MTOK; m += NGW) {
        f32x4 v[4]; float s = 0.f;
#pragma unroll
        for (int j = 0; j < 4; ++j) { v[j] = vn[j]; s += (v[j][0] + v[j][1]) + (v[j][2] + v[j][3]); }
        if (m + NGW < MTOK) { const GAS f32x4* xr = (const GAS f32x4*)(Y + (size_t)(m + NGW) * DM) + lane;
#pragma unroll
            for (int j = 0; j < 4; ++j) vn[j] = xr[64 * j]; }
        const float mean = wave_sum(s) * (1.f / DM); float s2 = 0.f;
#pragma unroll
        for (int j = 0; j < 4; ++j) { const f32x4 d = v[j] - mean; s2 += (d[0] * d[0] + d[1] * d[1]) + (d[2] * d[2] + d[3] * d[3]); }
        const float rstd = 1.f / sqrtf(wave_sum(s2) * (1.f / DM) + LN_EPS);
        if (FINAL) {
            GAS f32x4* xo = (GAS f32x4*)(X + (size_t)m * DM) + lane;
#pragma unroll
            for (int j = 0; j < 4; ++j) xo[64 * j] = (v[j] - mean) * rstd * gv[j] + bv[j];
        } else {
            if (lane == 0) *(GAS f32x2e*)(ST + (size_t)m * 2) = (f32x2e){mean, rstd};
            GAS u32x2* bo = (GAS u32x2*)(XB + (size_t)m * DM) + lane;
#pragma unroll
            for (int j = 0; j < 4; ++j) { const f32x4 o = (v[j] - mean) * rstd * gv[j] + bv[j]; u32x2 w; w.x = pk2(o[0], o[1]); w.y = pk2(o[2], o[3]); bo[64 * j] = w; }
        }
    }
}

__device__ __forceinline__ void gm_gate_phase(const GAS bf16* VT, const GAS bf16* U, GAS bf16* Gh, const GAS float* w_s, const GAS float* b_s, const GAS float* ln_g, const GAS float* ln_b, const GAS float* PS,
                                              unsigned char* lds, int tid, int lane, int wave) {
    LAS float* red = (LAS float*)lds;
    LAS float* stat = (LAS float*)((LAS unsigned char*)lds + 32768);
    for (int unit = blockIdx.x; unit < 256; unit += gridDim.x) {
        const int ch = unit >> 1, hh2 = unit & 1;
        const GAS bf16* vt = VT + (size_t)ch * 3072 * 128;
        {
            typedef float f32x2e __attribute__((ext_vector_type(2)));
            if (tid < 128) {
                const GAS f32x2e* pp = (const GAS f32x2e*)PS + (size_t)(ch * 128 + tid) * 48;
                float S = 0.f, Q = 0.f;
#pragma unroll 16
                for (int kx = 0; kx < 48; ++kx) { const f32x2e v = pp[kx]; S += v.x; Q += v.y; }
                const float mean = S * (1.f / 3072.f); const float var = Q * (1.f / 3072.f) - mean * mean;
                stat[tid] = mean; stat[128 + tid] = 1.f / sqrtf(var + LN_EPS);
            }
            __syncthreads();
        }
        const int tt = wave, n = lane & 15, kq = lane >> 4, t = 16 * tt + n;
        const int nks = (tt >> 1) + 1;
        LAS unsigned char* tb0 = (LAS unsigned char*)lds + 36864;
        constexpr int TROW = 272, TBUF = 192 * TROW;
        u32x4 tr[6];
#pragma unroll
        for (int q6 = 0; q6 < 6; ++q6) { const int q = tid + 512 * q6; tr[q6] = *(const GAS u32x4*)(vt + (size_t)((8 * hh2) * 192 + (q >> 4)) * 128 + (q & 15) * 8); }
#pragma unroll
        for (int q6 = 0; q6 < 6; ++q6) { const int q = tid + 512 * q6; *(LAS u32x4*)(tb0 + (q >> 4) * TROW + (q & 15) * 16) = tr[q6]; }
        __syncthreads();
        for (int gi = 0; gi < 8; ++gi) {
            const int g = 8 * hh2 + gi;
            if (gi + 1 < 8) {
#pragma unroll
                for (int q6 = 0; q6 < 6; ++q6) { const int q = tid + 512 * q6; tr[q6] = *(const GAS u32x4*)(vt + (size_t)((g + 1) * 192 + (q >> 4)) * 128 + (q & 15) * 8); }
            }
            const LAS unsigned char* tb = tb0 + (gi & 1) * TBUF;
            const GAS float* Wg = w_s + (size_t)g * 128 * 128 + (size_t)t * 128;
            bf16x8 bw[4]; float r0 = 0.f, r1 = 0.f;
#pragma unroll
            for (int ks = 0; ks < 4; ++ks) {
                bw[ks] = (bf16x8){0, 0, 0, 0, 0, 0, 0, 0};
                if (ks < nks) {
                    const int s0 = 32 * ks + 8 * kq;
                    const f32x4 wa = *(const GAS f32x4*)(Wg + s0), wb = *(const GAS f32x4*)(Wg + s0 + 4);
                    float w[8] = {wa[0], wa[1], wa[2], wa[3], wb[0], wb[1], wb[2], wb[3]};
                    unsigned hb[8];
#pragma unroll
                    for (int e = 0; e < 8; ++e) { const int s = s0 + e; const float wv = (s <= t) ? w[e] : 0.f; r0 += wv; const unsigned bb = f2bf(wv * stat[128 + s]); hb[e] = bb; r1 += bf2f(bb) * stat[s]; }
                    u32x4 pk; pk.x = hb[0] | (hb[1] << 16); pk.y = hb[2] | (hb[3] << 16); pk.z = hb[4] | (hb[5] << 16); pk.w = hb[6] | (hb[7] << 16);
                    bw[ks] = __builtin_bit_cast(bf16x8, pk);
                }
            }
            r0 += __shfl_xor(r0, 16); r0 += __shfl_xor(r0, 32); r1 += __shfl_xor(r1, 16); r1 += __shfl_xor(r1, 32);
            f32x4 acc[12];
#pragma unroll
            for (int ct = 0; ct < 12; ++ct) acc[ct] = (f32x4){0.f, 0.f, 0.f, 0.f};
#pragma unroll
            for (int ks = 0; ks < 4; ++ks) {
                if (ks < nks) {
#pragma unroll
                    for (int ct = 0; ct < 12; ++ct) {
                        const bf16x8 a = *(const LAS bf16x8*)(tb + (16 * ct + n) * TROW + 64 * ks + 16 * kq);
                        acc[ct] = mfma16(a, bw[ks], acc[ct]);
                    }
                }
            }
            const float bsv = b_s[g * 128 + t];
            const size_t rowoff = (size_t)(ch * 128 + t) * 3072;
#pragma unroll
            for (int ct = 0; ct < 12; ++ct) {
                const int cc = g * 192 + 16 * ct + 4 * kq;
                const f32x4 lg = *(const GAS f32x4*)(ln_g + cc), lb = *(const GAS f32x4*)(ln_b + cc);
                const u32x2 uu = *(const GAS u32x2*)(U + rowoff + cc);
                const float u0 = bf2f(uu.x & 0xffffu), u1 = bf2f(uu.x >> 16), u2 = bf2f(uu.y & 0xffffu), u3 = bf2f(uu.y >> 16);
                const float v0 = lg[0] * (acc[ct][0] - r1) + lb[0] * r0 + bsv, v1 = lg[1] * (acc[ct][1] - r1) + lb[1] * r0 + bsv;
                const float v2 = lg[2] * (acc[ct][2] - r1) + lb[2] * r0 + bsv, v3 = lg[3] * (acc[ct][3] - r1) + lb[3] * r0 + bsv;
                u32x2 o; o.x = pk2(u0 * v0, u1 * v1); o.y = pk2(u2 * v2, u3 * v3);
                *(GAS u32x2*)(Gh + rowoff + cc) = o;
            }
            if (gi + 1 < 8) {
                LAS unsigned char* tn = tb0 + ((gi + 1) & 1) * TBUF;
#pragma unroll
                for (int q6 = 0; q6 < 6; ++q6) { const int q = tid + 512 * q6; *(LAS u32x4*)(tn + (q >> 4) * TROW + (q & 15) * 16) = tr[q6]; }
            }
            __syncthreads();
        }
    }
}

__device__ __forceinline__ void compress_phase(const Params& p, unsigned char* lds, int tid, int lane, int wave) {
    unsigned char* ws = launder_ptr(p.ws);
    const GAS float* cosT = (const GAS float*)(ws + WS_COS); const GAS float* sinT = (const GAS float*)(ws + WS_SIN);
    const GAS float* cbg = (const GAS float*)(ws + WS_CB);
    LAS bf16* hball = (LAS bf16*)((LAS unsigned char*)lds + 2048);
    LAS unsigned char* wt0 = (LAS unsigned char*)lds + 36864;
    constexpr int WROW = 144, WBUF = 256 * WROW;
    const int r = lane & 15, kq = lane >> 4; const int rt = wave >> 1, hh = wave & 1;
    LAS bf16* hbuf = hball + rt * 16 * 264;
    for (int unit = blockIdx.x; unit < 256; unit += gridDim.x) {
        const int kv = unit >> 7, b = (unit >> 6) & 1, g = (unit >> 4) & 3, ntq = unit & 15;
        const int n0 = 64 * ntq + 16 * rt; const int nrow = n0 + r; const int nn = nrow < 1022 ? nrow : 1022;
        const GAS bf16* src = (const GAS bf16*)(ws + (kv ? R1_VC : R1_KC)) + ((size_t)(b * SEQ + 16 * nn)) * 256 + g * 64;
        const GAS bf16* W1t = (const GAS bf16*)(ws + (kv ? WS_W1V : WS_W1K));
        const GAS bf16* W2t = (const GAS bf16*)(ws + (kv ? WS_W2V : WS_W2K));
        f32x4 acc[8];
#pragma unroll
        for (int i = 0; i < 8; ++i) acc[i] = (f32x4){0.f, 0.f, 0.f, 0.f};
        u32x4 wr4[4];
#pragma unroll
        for (int q4 = 0; q4 < 4; ++q4) { const int q = tid + 512 * q4; wr4[q4] = *(const GAS u32x4*)(W1t + (size_t)(q >> 3) * 2048 + (q & 7) * 8); }
#pragma unroll
        for (int q4 = 0; q4 < 4; ++q4) { const int q = tid + 512 * q4; *(LAS u32x4*)(wt0 + (q >> 3) * WROW + (q & 7) * 16) = wr4[q4]; }
        __syncthreads();
        for (int kc = 0; kc < 32; ++kc) {
            if (kc + 1 < 32) {
#pragma unroll
                for (int q4 = 0; q4 < 4; ++q4) { const int q = tid + 512 * q4; wr4[q4] = *(const GAS u32x4*)(W1t + (size_t)(q >> 3) * 2048 + 64 * (kc + 1) + (q & 7) * 8); }
            }
            const LAS unsigned char* wt = wt0 + (kc & 1) * WBUF;
#pragma unroll
            for (int k2 = 0; k2 < 2; ++k2) {
                const int ks = 2 * kc + k2;
                const bf16x8 a = *(const GAS bf16x8*)(src + (size_t)(ks >> 1) * 256 + (ks & 1) * 32 + 8 * kq);
#pragma unroll
                for (int nt = 0; nt < 8; ++nt) {
                    const bf16x8 bfr = *(const LAS bf16x8*)(wt + (128 * hh + 16 * nt + r) * WROW + 64 * k2 + 16 * kq);
                    acc[nt] = mfma16(a, bfr, acc[nt]);
                }
            }
            if (kc + 1 < 32) {
                LAS unsigned char* wn = wt0 + ((kc + 1) & 1) * WBUF;
#pragma unroll
                for (int q4 = 0; q4 < 4; ++q4) { const int q = tid + 512 * q4; *(LAS u32x4*)(wn + (q >> 3) * WROW + (q & 7) * 16) = wr4[q4]; }
            }
            __syncthreads();
        }
#pragma unroll
        for (int nt = 0; nt < 8; ++nt) {
            const float bias = cbg[kv * 256 + 128 * hh + 16 * nt + r];
#pragma unroll
            for (int i = 0; i < 4; ++i) hbuf[(4 * kq + i) * 264 + 128 * hh + 16 * nt + r] = (bf16)f2bf(pg8::gelu_tanh_f(acc[nt][i] + bias));
        }
        __syncthreads();
        f32x4 o[2];
        o[0] = (f32x4){0.f, 0.f, 0.f, 0.f}; o[1] = (f32x4){0.f, 0.f, 0.f, 0.f};
#pragma unroll
        for (int k2 = 0; k2 < 8; ++k2) {
            const bf16x8 a = *(const LAS bf16x8*)(hbuf + r * 264 + 32 * k2 + 8 * kq);
#pragma unroll
            for (int e = 0; e < 2; ++e) {
                const bf16x8 bfr = *(const GAS bf16x8*)(W2t + (size_t)(16 * (hh + 2 * e) + r) * 256 + 32 * k2 + 8 * kq);
                o[e] = mfma16(a, bfr, o[e]);
            }
        }
#pragma unroll
        for (int i = 0; i < 4; ++i) {
            const int n = n0 + 4 * kq + i; const bool valid = n < 1023;
            if (kv == 0) {
                int pos = 16 * n + 31; if (pos > SEQ - 1) pos = SEQ - 1;
                GAS bf16* dst = (GAS bf16*)(ws + R1_KCMP) + ((size_t)(b * 4 + g) * 1024 + n) * 64;
                const int dl = 16 * hh + r; const float cs = cosT[pos * 32 + dl], sn = sinT[pos * 32 + dl];
                const float x1 = o[0][i], x2 = o[1][i];
                dst[dl] = valid ? (bf16)f2bf(x1 * cs - x2 * sn) : (bf16)0; dst[dl + 32] = valid ? (bf16)f2bf(x2 * cs + x1 * sn) : (bf16)0;
            } else {
                GAS bf16* dst = (GAS bf16*)(ws + R1_VCMPT) + (((size_t)(b * 4 + g) * 16 + (n >> 6)) * 64) * 64 + pg8::kpos64(n & 63);
#pragma unroll
                for (int e = 0; e < 2; ++e) dst[(size_t)(16 * (hh + 2 * e) + r) * 64] = valid ? (bf16)f2bf(o[e][i]) : (bf16)0;
            }
        }
        __syncthreads();
    }
}

typedef LAS unsigned char* ldsp_t;
typedef const LAS unsigned char* cldsp_t;
typedef const GAS bf16* gbf_t;
constexpr int A2_KV = 0, A2_IMP = 36864, A2_SEL = 102400, A2_PT = 104448 + 64, A2_PT2 = A2_PT + 8 * 2304, KROW = 144, KBUF = 9216;

template <int CTRL> __device__ __forceinline__ float dpp_f(float v) { return __builtin_bit_cast(float, __builtin_amdgcn_update_dpp(__builtin_bit_cast(int, v), __builtin_bit_cast(int, v), CTRL, 0xf, 0xf, false)); }
template <int CTRL> __device__ __forceinline__ unsigned dpp_u(unsigned v) { return (unsigned)__builtin_amdgcn_update_dpp((int)v, (int)v, CTRL, 0xf, 0xf, false); }
__device__ __forceinline__ float row16_max(float v) { v = fmaxf(v, dpp_f<0x128>(v)); v = fmaxf(v, dpp_f<0x124>(v)); v = fmaxf(v, dpp_f<0x122>(v)); v = fmaxf(v, dpp_f<0x121>(v)); return v; }
__device__ __forceinline__ float row16_sum(float v) { v += dpp_f<0x128>(v); v += dpp_f<0x124>(v); v += dpp_f<0x122>(v); v += dpp_f<0x121>(v); return v; }
__device__ __forceinline__ unsigned umax2(unsigned a, unsigned b) { return a > b ? a : b; }
__device__ __forceinline__ unsigned wave_max_u32(unsigned v) {
    v = umax2(v, dpp_u<0x111>(v)); v = umax2(v, dpp_u<0x112>(v)); v = umax2(v, dpp_u<0x114>(v)); v = umax2(v, dpp_u<0x118>(v));
    v = umax2(v, (unsigned)__builtin_amdgcn_update_dpp((int)v, (int)v, 0x142, 0xa, 0xf, false));
    v = umax2(v, (unsigned)__builtin_amdgcn_update_dpp((int)v, (int)v, 0x143, 0xc, 0xf, false));
    return (unsigned)__builtin_amdgcn_readlane((int)v, 63);
}

#define A2_BAR() asm volatile("s_waitcnt lgkmcnt(0)\n\ts_barrier" ::: "memory")
__device__ __forceinline__ float max3f(float a, float b, float c) { return fmaxf(fmaxf(a, b), c); }
template <int MODE, int PASS, int TSEL = -1>
__device__ __forceinline__ void attn_block(int kb, cldsp_t Kl, cldsp_t Vl, int t_base, ldsp_t lds, const bf16x8 (&qA)[2][2],
                                           float (&m)[2][4], float (&l)[2][4], const float (&il)[2][4], f32x4 (&o)[2][4], int lane, int wave, unsigned wsel = 0u) {
    const int n = lane & 15, rq = lane >> 4;
    LAS bf16* Pt = (LAS bf16*)(lds + A2_PT + wave * 2304);
    LAS float* imp = (LAS float*)(lds + A2_IMP);
    const LAS unsigned* selm = (const LAS unsigned*)(lds + A2_SEL);
#pragma unroll
    for (int T = 0; T < 2; ++T) {
        const int tq = t_base + 8 * wave + 4 * T + rq;
        bool sb = true;
        if (TSEL >= 0) { if (T != TSEL) continue; sb = ((wsel >> (kb & 31)) & 1u) != 0u; }
        else if (MODE == 2) { const unsigned wv = selm[(8 * wave + 4 * T + rq) * 8 + (kb >> 5)]; sb = ((wv >> (kb & 31)) & 1u) != 0u; if (__builtin_amdgcn_ballot_w64(sb) == 0ull) continue; }
        float pr[4][4];
        bool fast = false;
        if (PASS >= 2) {
            fast = (MODE == 0) ? (1024 * kb + 1039 <= t_base) : (MODE == 1) ? (64 * kb + 63 <= t_base && 64 * kb > t_base + 63 - 512) : (kb != (t_base >> 6));
            if (fast) {
                f32x4 ci;
#pragma unroll
                for (int i = 0; i < 4; ++i) ci[i] = sb ? -m[T][i] : -1e30f;
                f32x4 s[4];
#pragma unroll
                for (int j = 0; j < 4; ++j) {
                    cldsp_t kp = Kl + (16 * j + n) * KROW + 16 * rq;
                    s[j] = mfma16(qA[T][0], *(const LAS bf16x8*)kp, ci); s[j] = mfma16(qA[T][1], *(const LAS bf16x8*)(kp + 64), s[j]);
                }
                float mx = max3f(max3f(s[0][0], s[0][1], s[0][2]), max3f(s[0][3], s[1][0], s[1][1]), max3f(s[1][2], s[1][3], s[2][0]));
                mx = max3f(mx, max3f(s[2][1], s[2][2], s[2][3]), max3f(s[3][0], s[3][1], max3f(s[3][2], s[3][3], mx)));
                if (PASS != 2 && __builtin_amdgcn_ballot_w64(mx > 8.0f) != 0ull) fast = false;
                else {
#pragma unroll
                    for (int j = 0; j < 4; ++j)
#pragma unroll
                        for (int i = 0; i < 4; ++i) pr[j][i] = PASS == 2 ? __builtin_amdgcn_exp2f(s[j][i]) * il[T][i] : __builtin_amdgcn_exp2f(s[j][i]);
                    if (PASS != 2) {
#pragma unroll
                        for (int i = 0; i < 4; ++i) l[T][i] += (pr[0][i] + pr[1][i]) + (pr[2][i] + pr[3][i]);
                    }
                }
            }
        }
        if (!fast) {
            f32x4 s[4]; bool vis[4];
#pragma unroll
            for (int j = 0; j < 4; ++j) {
                cldsp_t kp = Kl + (16 * j + n) * KROW + 16 * rq;
                s[j] = (f32x4){0.f, 0.f, 0.f, 0.f};
                s[j] = mfma16(qA[T][0], *(const LAS bf16x8*)kp, s[j]); s[j] = mfma16(qA[T][1], *(const LAS bf16x8*)(kp + 64), s[j]);
                const int key = 64 * kb + 16 * j + n;
                vis[j] = MODE == 0 ? (16 * key + 31 <= tq) : MODE == 1 ? (key <= tq && key > tq - 512) : (sb && key <= tq);
            }
            if (PASS == 1) {
#pragma unroll
                for (int j = 0; j < 4; ++j)
                    if (vis[j]) {
#pragma unroll
                        for (int i = 0; i < 4; ++i) { const float mn = fmaxf(m[T][i], s[j][i]); l[T][i] = l[T][i] * __builtin_amdgcn_exp2f(m[T][i] - mn) + __builtin_amdgcn_exp2f(s[j][i] - mn); m[T][i] = mn; }
                    }
            } else if (PASS == 2) {
#pragma unroll
                for (int j = 0; j < 4; ++j)
#pragma unroll
                    for (int i = 0; i < 4; ++i) pr[j][i] = vis[j] ? __builtin_amdgcn_exp2f(s[j][i] - m[T][i]) * il[T][i] : 0.f;
            } else {
                float mn[4], al[4];
#pragma unroll
                for (int i = 0; i < 4; ++i) {
                    const float a0 = vis[0] ? s[0][i] : -1e30f, a1 = vis[1] ? s[1][i] : -1e30f, a2 = vis[2] ? s[2][i] : -1e30f, a3 = vis[3] ? s[3][i] : -1e30f;
                    const float tm = row16_max(fmaxf(fmaxf(a0, a1), fmaxf(a2, a3)));
                    mn[i] = (tm > m[T][i] + 8.0f || m[T][i] < -1e29f) ? fmaxf(m[T][i], tm) : m[T][i];
                    al[i] = __builtin_amdgcn_exp2f(m[T][i] - mn[i]); m[T][i] = mn[i];
                }
#pragma unroll
                for (int j = 0; j < 4; ++j)
#pragma unroll
                    for (int i = 0; i < 4; ++i) pr[j][i] = vis[j] ? __builtin_amdgcn_exp2f(s[j][i] - mn[i]) : 0.f;
#pragma unroll
                for (int i = 0; i < 4; ++i) {
                    l[T][i] = l[T][i] * al[i] + ((pr[0][i] + pr[1][i]) + (pr[2][i] + pr[3][i]));
                    if (PASS == 3) {
#pragma unroll
                        for (int dt = 0; dt < 4; ++dt) o[T][dt][i] *= al[i];
                    }
                }
            }
        }
        if (PASS == 2 || PASS == 3) {
#pragma unroll
            for (int c2 = 0; c2 < 2; ++c2) {
                LAS unsigned* pw32 = (LAS unsigned*)(Pt + (4 * rq) * 72 + 32 * c2 + 2 * n);
#pragma unroll
                for (int i = 0; i < 4; ++i) pw32[36 * i] = pk2(pr[2 * c2][i], pr[2 * c2 + 1][i]);
            }
#pragma unroll
            for (int j = 0; j < 4; ++j) {
                if (MODE == 0) {
                    const int key = 64 * kb + 16 * j + n;
                    const float ps = (pr[j][0] + pr[j][1]) + (pr[j][2] + pr[j][3]);
                    float qs = ps + dpp_f<0xB1>(ps); qs += dpp_f<0x4E>(qs);
                    if ((n & 3) == 3) { const int jj = key >> 2; LAS float* ip = imp + (8 * wave + 4 * T + rq) * 256;
                        (void)__hip_atomic_fetch_add(ip + jj, qs, __ATOMIC_RELAXED, __HIP_MEMORY_SCOPE_WORKGROUP); if (jj + 1 < 256) (void)__hip_atomic_fetch_add(ip + jj + 1, ps, __ATOMIC_RELAXED, __HIP_MEMORY_SCOPE_WORKGROUP); }
                }
            }
            bf16x8 vf[4][2];
#pragma unroll
            for (int dt = 0; dt < 4; ++dt) { cldsp_t vp = Vl + (16 * dt + n) * KROW + 16 * rq; vf[dt][0] = *(const LAS bf16x8*)vp; vf[dt][1] = *(const LAS bf16x8*)(vp + 64); }
            asm volatile("s_waitcnt lgkmcnt(0)" ::: "memory");
            const bf16x8 pa0 = *(const LAS bf16x8*)(Pt + n * 72 + 8 * rq), pa1 = *(const LAS bf16x8*)(Pt + n * 72 + 32 + 8 * rq);
#pragma unroll
            for (int dt = 0; dt < 4; ++dt) { o[T][dt] = mfma16(pa0, vf[dt][0], o[T][dt]); o[T][dt] = mfma16(pa1, vf[dt][1], o[T][dt]); }
            asm volatile("s_waitcnt lgkmcnt(0)" ::: "memory");
        }
    }
}

template <int MODE, int PASS>
__device__ __forceinline__ void attn_block2(int kb, cldsp_t Kl, cldsp_t Vl, int t_base, ldsp_t lds, const bf16x8 (&qA)[2][2],
                                            float (&m)[2][4], float (&l)[2][4], const float (&il)[2][4], f32x4 (&o)[2][4], float (&carry)[2], int lane, int wave) {
    const int n = lane & 15, rq = lane >> 4;
    LAS float* imp = (LAS float*)(lds + A2_IMP);
    const bool full = (MODE == 0) ? (1024 * kb + 1039 <= t_base) : (MODE == 1) ? (64 * kb + 63 <= t_base && 64 * kb > t_base + 63 - 512) : (kb != (t_base >> 6));
    bool sbt[2] = {true, true};
    if (MODE == 2) {
        const LAS unsigned* selm = (const LAS unsigned*)(lds + A2_SEL);
#pragma unroll
        for (int T = 0; T < 2; ++T) { const unsigned wv = selm[(8 * wave + 4 * T + rq) * 8 + (kb >> 5)]; sbt[T] = ((wv >> (kb & 31)) & 1u) != 0u; }
    }
    bf16x8 kf[4][2];
#pragma unroll
    for (int j = 0; j < 4; ++j) { cldsp_t kp = Kl + (16 * j + n) * KROW + 16 * rq; kf[j][0] = *(const LAS bf16x8*)kp; kf[j][1] = *(const LAS bf16x8*)(kp + 64); }
    f32x4 s[2][4];
    bool fast = full;
    if (fast) {
#pragma unroll
        for (int T = 0; T < 2; ++T) {
            f32x4 ci;
#pragma unroll
            for (int i = 0; i < 4; ++i) ci[i] = (MODE == 2 && !sbt[T]) ? -1e30f : -m[T][i];
#pragma unroll
            for (int j = 0; j < 4; ++j) { s[T][j] = mfma16(qA[T][0], kf[j][0], ci); s[T][j] = mfma16(qA[T][1], kf[j][1], s[T][j]); }
        }
        if (PASS != 2) {
            float mx = -1e30f;
#pragma unroll
            for (int T = 0; T < 2; ++T)
#pragma unroll
                for (int j = 0; j < 4; ++j) mx = max3f(mx, fmaxf(s[T][j][0], s[T][j][1]), fmaxf(s[T][j][2], s[T][j][3]));
            if (__builtin_amdgcn_ballot_w64(mx > 8.0f) != 0ull) fast = false;
        }
    }
    if (!fast) {
        const f32x4 z = (f32x4){0.f, 0.f, 0.f, 0.f};
#pragma unroll
        for (int T = 0; T < 2; ++T)
#pragma unroll
            for (int j = 0; j < 4; ++j) { s[T][j] = mfma16(qA[T][0], kf[j][0], z); s[T][j] = mfma16(qA[T][1], kf[j][1], s[T][j]); }
    }
    bf16x8 vf[4][2];
#pragma unroll
    for (int T = 0; T < 2; ++T) {
        float pr[4][4];
        if (fast) {
#pragma unroll
            for (int j = 0; j < 4; ++j)
#pragma unroll
                for (int i = 0; i < 4; ++i) pr[j][i] = PASS == 2 ? __builtin_amdgcn_exp2f(s[T][j][i]) * il[T][i] : __builtin_amdgcn_exp2f(s[T][j][i]);
            if (PASS != 2) {
#pragma unroll
                for (int i = 0; i < 4; ++i) l[T][i] += (pr[0][i] + pr[1][i]) + (pr[2][i] + pr[3][i]);
            }
        } else {
            const int tq = t_base + 8 * wave + 4 * T + rq;
            bool vis[4];
#pragma unroll
            for (int j = 0; j < 4; ++j) { const int key = 64 * kb + 16 * j + n; vis[j] = MODE == 0 ? (16 * key + 31 <= tq) : MODE == 1 ? (key <= tq && key > tq - 512) : (sbt[T] && key <= tq); }
            if (PASS == 2) {
#pragma unroll
                for (int j = 0; j < 4; ++j)
#pragma unroll
                    for (int i = 0; i < 4; ++i) pr[j][i] = vis[j] ? __builtin_amdgcn_exp2f(s[T][j][i] - m[T][i]) * il[T][i] : 0.f;
            } else {
                float mn[4], al[4];
#pragma unroll
                for (int i = 0; i < 4; ++i) {
                    const float a0 = vis[0] ? s[T][0][i] : -1e30f, a1 = vis[1] ? s[T][1][i] : -1e30f, a2 = vis[2] ? s[T][2][i] : -1e30f, a3 = vis[3] ? s[T][3][i] : -1e30f;
                    const float tm = row16_max(fmaxf(fmaxf(a0, a1), fmaxf(a2, a3)));
                    mn[i] = (tm > m[T][i] + 8.0f || m[T][i] < -1e29f) ? fmaxf(m[T][i], tm) : m[T][i];
                    al[i] = __builtin_amdgcn_exp2f(m[T][i] - mn[i]); m[T][i] = mn[i];
                }
#pragma unroll
                for (int j = 0; j < 4; ++j)
#pragma unroll
                    for (int i = 0; i < 4; ++i) pr[j][i] = vis[j] ? __builtin_amdgcn_exp2f(s[T][j][i] - mn[i]) : 0.f;
#pragma unroll
                for (int i = 0; i < 4; ++i) {
                    l[T][i] = l[T][i] * al[i] + ((pr[0][i] + pr[1][i]) + (pr[2][i] + pr[3][i]));
                    if (PASS == 3) {
#pragma unroll
                        for (int dt = 0; dt < 4; ++dt) o[T][dt][i] *= al[i];
                    }
                }
            }
        }
        if (PASS == 2 || PASS == 3) {
            LAS bf16* Pt = (LAS bf16*)(lds + (T == 0 ? A2_PT : A2_PT2) + wave * 2304);
#pragma unroll
            for (int c2 = 0; c2 < 2; ++c2) {
                LAS unsigned* pw32 = (LAS unsigned*)(Pt + (4 * rq) * 72 + 32 * c2 + 2 * n);
#pragma unroll
                for (int i = 0; i < 4; ++i) pw32[36 * i] = pk2(pr[2 * c2][i], pr[2 * c2 + 1][i]);
            }
#pragma unroll
            for (int j = 0; j < 4; ++j) {
            }
            if (MODE == 0) {
                float rp_prev = carry[T];
                float binv[4];
#pragma unroll
                for (int j = 0; j < 4; ++j) {
                    const float ps = (pr[j][0] + pr[j][1]) + (pr[j][2] + pr[j][3]);
                    float qs = ps + dpp_f<0xB1>(ps); qs += dpp_f<0x4E>(qs);
                    const float rp = dpp_f<0x121>(ps);
                    binv[j] = qs + (n == 0 ? rp_prev : rp);
                    rp_prev = rp;
                }
                carry[T] = rp_prev;
                if ((n & 3) == 0) { LAS float* ip = imp + (8 * wave + 4 * T + rq) * 256 + 16 * kb + (n >> 2);
#pragma unroll
                    for (int j = 0; j < 4; ++j) ip[4 * j] = binv[j]; }
            }
            if (T == 0) {
#pragma unroll
                for (int dt = 0; dt < 4; ++dt) { cldsp_t vp = Vl + (16 * dt + n) * KROW + 16 * rq; vf[dt][0] = *(const LAS bf16x8*)vp; vf[dt][1] = *(const LAS bf16x8*)(vp + 64); }
            }
            asm volatile("s_waitcnt lgkmcnt(0)" ::: "memory");
            { const bf16x8 pa0 = *(const LAS bf16x8*)(Pt + n * 72 + 8 * rq), pa1 = *(const LAS bf16x8*)(Pt + n * 72 + 32 + 8 * rq);
#pragma unroll
              for (int dt = 0; dt < 4; ++dt) { o[T][dt] = mfma16(pa0, vf[dt][0], o[T][dt]); o[T][dt] = mfma16(pa1, vf[dt][1], o[T][dt]); } }
        }
    }
}

__device__ __forceinline__ unsigned opaque_u32(unsigned v) { asm volatile("" : "+v"(v)); return v; }
template <int MODE, int PASS>
__device__ __forceinline__ void attn_loop(gbf_t Kg, gbf_t VTg, int kb_lo, int kb_hi, int t_base, ldsp_t lds, const bf16x8 (&qA)[2][2],
                                          float (&m)[2][4], float (&l)[2][4], const float (&il)[2][4], f32x4 (&o)[2][4], int tid, int lane, int wave) {
    float carry[2] = {0.f, 0.f};
    constexpr int D = 2;
    constexpr bool HASV = !(PASS == 1 || PASS == 4);
    ldsp_t Kb0 = lds + A2_KV; ldsp_t Vb0 = lds + A2_KV + 2 * KBUF;
    const int soff = (tid >> 3) * KROW + (tid & 7) * 16;
    const unsigned goff = (unsigned)tid * 16u;
    const u32x4 zz = (u32x4){0u, 0u, 0u, 0u};
#define A2_LDK(kk) (*(const GAS u32x4*)((const GAS unsigned char*)(Kg + (size_t)(kk) * 4096) + opaque_u32(goff)))
#define A2_LDV(kk) (*(const GAS u32x4*)((const GAS unsigned char*)(VTg + (size_t)(kk) * 4096) + opaque_u32(goff)))
    u32x4 kr[D], vr[D];
#pragma unroll
    for (int s = 0; s < D; ++s) {
        kr[s] = zz; vr[s] = zz;
        if (kb_lo + s < kb_hi) { kr[s] = A2_LDK(kb_lo + s); if (HASV) vr[s] = A2_LDV(kb_lo + s); }
    }
    *(LAS u32x4*)(Kb0 + soff) = kr[0]; if (HASV) *(LAS u32x4*)(Vb0 + soff) = vr[0];
    if (kb_lo + D < kb_hi) { kr[0] = A2_LDK(kb_lo + D); if (HASV) vr[0] = A2_LDV(kb_lo + D); }
    A2_BAR();
    for (int kb4 = kb_lo; kb4 < kb_hi; kb4 += D) {
#pragma unroll
        for (int s = 0; s < D; ++s) {
            const int k = kb4 + s;
            if (k < kb_hi) {
                const int s1 = (s + 1) % D;
                if (k + 1 < kb_hi) { *(LAS u32x4*)(Kb0 + ((s + 1) & 1) * KBUF + soff) = kr[s1]; if (HASV) *(LAS u32x4*)(Vb0 + ((s + 1) & 1) * KBUF + soff) = vr[s1]; }
                if (k + 1 + D < kb_hi) { kr[s1] = A2_LDK(k + 1 + D); if (HASV) vr[s1] = A2_LDV(k + 1 + D); }
                if (MODE == 2) {
                    const LAS unsigned* selm_ = (const LAS unsigned*)(lds + A2_SEL);
                    const int rq_ = lane >> 4;
                    const unsigned w0_ = selm_[(8 * wave + rq_) * 8 + (k >> 5)], w1_ = selm_[(8 * wave + 4 + rq_) * 8 + (k >> 5)];
                    const bool h0_ = __builtin_amdgcn_ballot_w64(((w0_ >> (k & 31)) & 1u) != 0u) != 0ull, h1_ = __builtin_amdgcn_ballot_w64(((w1_ >> (k & 31)) & 1u) != 0u) != 0ull;
                    if (h0_ && h1_) attn_block2<MODE, PASS>(k, Kb0 + (s & 1) * KBUF, Vb0 + (s & 1) * KBUF, t_base, lds, qA, m, l, il, o, carry, lane, wave);
                    else if (h0_) attn_block<MODE, PASS, 0>(k, Kb0 + (s & 1) * KBUF, Vb0 + (s & 1) * KBUF, t_base, lds, qA, m, l, il, o, lane, wave, w0_);
                    else if (h1_) attn_block<MODE, PASS, 1>(k, Kb0 + (s & 1) * KBUF, Vb0 + (s & 1) * KBUF, t_base, lds, qA, m, l, il, o, lane, wave, w1_);
                } else attn_block2<MODE, PASS>(k, Kb0 + (s & 1) * KBUF, Vb0 + (s & 1) * KBUF, t_base, lds, qA, m, l, il, o, carry, lane, wave);
                A2_BAR();
            }
        }
    }
#undef A2_LDK
#undef A2_LDV
}

template <int MODE>
__device__ __forceinline__ void attn_branch(gbf_t Kg, gbf_t VTg, int kb_lo, int kb_hi, int t_base, ldsp_t lds, const bf16x8 (&qA)[2][2], f32x4 (&o)[2][4],
                                            const GAS float* gate0, int gidx, float gscale, int tid, int lane, int wave) {
    const int rq = lane >> 4;
    float m[2][4], l[2][4], il[2][4];
#pragma unroll
    for (int T = 0; T < 2; ++T) {
#pragma unroll
        for (int i = 0; i < 4; ++i) { m[T][i] = -1e30f; l[T][i] = 0.f; il[T][i] = 0.f; }
#pragma unroll
        for (int dt = 0; dt < 4; ++dt) o[T][dt] = (f32x4){0.f, 0.f, 0.f, 0.f};
    }
    if (MODE == 0) {
        attn_loop<MODE, 4>(Kg, VTg, kb_lo, kb_hi, t_base, lds, qA, m, l, il, o, tid, lane, wave);
#pragma unroll
        for (int T = 0; T < 2; ++T)
#pragma unroll
            for (int i = 0; i < 4; ++i) { const float ls = row16_sum(l[T][i]); il[T][i] = ls > 0.f ? 1.f / ls : 0.f; }
        attn_loop<MODE, 2>(Kg, VTg, kb_lo, kb_hi, t_base, lds, qA, m, l, il, o, tid, lane, wave);
#pragma unroll
        for (int T = 0; T < 2; ++T)
#pragma unroll
            for (int i = 0; i < 4; ++i) il[T][i] = 1.f;
    } else {
        attn_loop<MODE, 3>(Kg, VTg, kb_lo, kb_hi, t_base, lds, qA, m, l, il, o, tid, lane, wave);
#pragma unroll
        for (int T = 0; T < 2; ++T)
#pragma unroll
            for (int i = 0; i < 4; ++i) { const float ls = row16_sum(l[T][i]); il[T][i] = ls > 0.f ? 1.f / ls : 0.f; }
    }
#pragma unroll
    for (int T = 0; T < 2; ++T)
#pragma unroll
        for (int i = 0; i < 4; ++i) {
            const float gt = gate0[(size_t)(4 * T + rq) * 48 + i * 3 + gidx] * gscale * il[T][i];
#pragma unroll
            for (int dt = 0; dt < 4; ++dt) o[T][dt][i] *= gt;
        }
}

constexpr int A2_QS = A2_PT + 8 * 2304;
template <int Q>
__device__ __forceinline__ void sel_hit(int kb, bool diag, int t_base, ldsp_t lds, const bf16x8 (&kf)[4][2], cldsp_t Vl, f32x4& oq, f32x4& lq, int lane, int wave) {
    const int n = lane & 15, rq = lane >> 4;
    LAS bf16* Pq = (LAS bf16*)(lds + A2_PT + wave * 2304);
    LAS f32x4* mrefp = (LAS f32x4*)(lds + A2_PT + wave * 2304 + 1024) + Q;
    const LAS bf16* qp = (const LAS bf16*)(lds + A2_QS) + (8 * wave + Q) * 256 + (n & 3) * 64 + 8 * rq;
    const bf16x8 qf0 = *(const LAS bf16x8*)qp, qf1 = *(const LAS bf16x8*)(qp + 32);
    f32x4 mr = *mrefp;
    const int t = t_base + 8 * wave + Q; const int key = 64 * kb + 16 * rq + n;
    const bool vis = !diag || key <= t;
    const f32x4 ci = -mr;
    f32x4 c0 = mfma16(qf0, kf[0][0], ci), c1 = mfma16(qf0, kf[1][0], ci), c2 = mfma16(qf0, kf[2][0], ci), c3 = mfma16(qf0, kf[3][0], ci);
    c0 = mfma16(qf1, kf[0][1], c0); c1 = mfma16(qf1, kf[1][1], c1); c2 = mfma16(qf1, kf[2][1], c2); c3 = mfma16(qf1, kf[3][1], c3);
    f32x4 sp;
#pragma unroll
    for (int i = 0; i < 4; ++i) { const float v = rq == 0 ? c0[i] : rq == 1 ? c1[i] : rq == 2 ? c2[i] : c3[i]; sp[i] = vis ? v : -1e30f; }
    const float mx = max3f(sp[0], sp[1], fmaxf(sp[2], sp[3]));
    if (__builtin_amdgcn_ballot_w64(mx > 8.0f) != 0ull) {
        const f32x4 z = (f32x4){0.f, 0.f, 0.f, 0.f};
        c0 = mfma16(qf0, kf[0][0], z); c1 = mfma16(qf0, kf[1][0], z); c2 = mfma16(qf0, kf[2][0], z); c3 = mfma16(qf0, kf[3][0], z);
        c0 = mfma16(qf1, kf[0][1], c0); c1 = mfma16(qf1, kf[1][1], c1); c2 = mfma16(qf1, kf[2][1], c2); c3 = mfma16(qf1, kf[3][1], c3);
#pragma unroll
        for (int i = 0; i < 4; ++i) {
            const float v = rq == 0 ? c0[i] : rq == 1 ? c1[i] : rq == 2 ? c2[i] : c3[i];
            float hm = row16_max(vis ? v : -1e30f); hm = fmaxf(hm, __shfl_xor(hm, 16)); hm = fmaxf(hm, __shfl_xor(hm, 32));
            const float nr = (hm > mr[i] + 8.0f || mr[i] < -1e29f) ? fmaxf(mr[i], hm) : mr[i];
            const float al = __builtin_amdgcn_exp2f(mr[i] - nr);
            lq[i] *= al; oq[i] *= al; mr[i] = nr; sp[i] = vis ? v - nr : -1e30f;
        }
        if (lane == 0) *mrefp = mr;
    }
    f32x4 pv;
#pragma unroll
    for (int i = 0; i < 4; ++i) pv[i] = __builtin_amdgcn_exp2f(sp[i]);
    lq += pv;
    { const unsigned p01 = pk2(pv[0], pv[1]), p23 = pk2(pv[2], pv[3]);
      LAS bf16* pw = Pq + 16 * rq + n;
      pw[0] = (bf16)(p01 & 0xffffu); pw[72] = (bf16)(p01 >> 16); pw[144] = (bf16)(p23 & 0xffffu); pw[216] = (bf16)(p23 >> 16); }
    asm volatile("s_waitcnt lgkmcnt(0)" ::: "memory");
    const bf16x8 pa0 = *(const LAS bf16x8*)(Pq + (n & 3) * 72 + 8 * rq), pa1 = *(const LAS bf16x8*)(Pq + (n & 3) * 72 + 32 + 8 * rq);
    const f32x4 z = (f32x4){0.f, 0.f, 0.f, 0.f};
    bf16x8 vf[4][2];
#pragma unroll
    for (int j = 0; j < 4; ++j) { cldsp_t vp = Vl + (16 * j + n) * KROW + 16 * rq; vf[j][0] = *(const LAS bf16x8*)vp; vf[j][1] = *(const LAS bf16x8*)(vp + 64); }
    f32x4 o0 = mfma16(pa0, vf[0][0], z), o1 = mfma16(pa0, vf[1][0], z), o2 = mfma16(pa0, vf[2][0], z), o3 = mfma16(pa0, vf[3][0], z);
    o0 = mfma16(pa1, vf[0][1], o0); o1 = mfma16(pa1, vf[1][1], o1); o2 = mfma16(pa1, vf[2][1], o2); o3 = mfma16(pa1, vf[3][1], o3);
#pragma unroll
    for (int i = 0; i < 4; ++i) oq[i] += rq == 0 ? o0[i] : rq == 1 ? o1[i] : rq == 2 ? o2[i] : o3[i];
    asm volatile("s_waitcnt lgkmcnt(0)" ::: "memory");
}

__device__ __forceinline__ void sel_block(int kb, cldsp_t Kl, cldsp_t Vl, int t_base, ldsp_t lds, f32x4 (&o)[8], f32x4 (&l)[8], int lane, int wave) {
    const int n = lane & 15, rq = lane >> 4;
    const LAS unsigned* selm = (const LAS unsigned*)(lds + A2_SEL);
    unsigned wv = 0u; if (lane < 8) wv = selm[(8 * wave + lane) * 8 + (kb >> 5)];
    const unsigned qmask = (unsigned)__builtin_amdgcn_ballot_w64(((wv >> (kb & 31)) & 1u) != 0u) & 0xFFu;
    if (qmask == 0u) return;
    bf16x8 kf[4][2];
#pragma unroll
    for (int j = 0; j < 4; ++j) { cldsp_t kp = Kl + (16 * j + n) * KROW + 16 * rq; kf[j][0] = *(const LAS bf16x8*)kp; kf[j][1] = *(const LAS bf16x8*)(kp + 64); }
    const bool diag = kb == (t_base >> 6);
    if (qmask & 1u) sel_hit<0>(kb, diag, t_base, lds, kf, Vl, o[0], l[0], lane, wave);
    if (qmask & 2u) sel_hit<1>(kb, diag, t_base, lds, kf, Vl, o[1], l[1], lane, wave);
    if (qmask & 4u) sel_hit<2>(kb, diag, t_base, lds, kf, Vl, o[2], l[2], lane, wave);
    if (qmask & 8u) sel_hit<3>(kb, diag, t_base, lds, kf, Vl, o[3], l[3], lane, wave);
    if (qmask & 16u) sel_hit<4>(kb, diag, t_base, lds, kf, Vl, o[4], l[4], lane, wave);
    if (qmask & 32u) sel_hit<5>(kb, diag, t_base, lds, kf, Vl, o[5], l[5], lane, wave);
    if (qmask & 64u) sel_hit<6>(kb, diag, t_base, lds, kf, Vl, o[6], l[6], lane, wave);
    if (qmask & 128u) sel_hit<7>(kb, diag, t_base, lds, kf, Vl, o[7], l[7], lane, wave);
}

__device__ __forceinline__ void sel_branch(gbf_t Kg, gbf_t VTg, int kb_hi, int t_base, ldsp_t lds, const GAS float* gate0, float gscale, LAS float* stq, int tid, int lane, int wave) {
    const int n = lane & 15, rq = lane >> 4;
    constexpr int D = 2;
    ldsp_t Kb0 = lds + A2_KV; ldsp_t Vb0 = lds + A2_KV + 2 * KBUF;
    const int soff = (tid >> 3) * KROW + (tid & 7) * 16;
    const unsigned goff = (unsigned)tid * 16u;
    f32x4 o[8], l[8];
#pragma unroll
    for (int q = 0; q < 8; ++q) { o[q] = (f32x4){0.f, 0.f, 0.f, 0.f}; l[q] = (f32x4){0.f, 0.f, 0.f, 0.f}; }
    { float ng = -1e30f; asm volatile("" : "+v"(ng)); if (lane < 8) ((LAS f32x4*)(lds + A2_PT + wave * 2304 + 1024))[lane] = (f32x4){ng, ng, ng, ng}; }
#define S2_LDK(kk) (*(const GAS u32x4*)((const GAS unsigned char*)(Kg + (size_t)(kk) * 4096) + goff))
#define S2_LDV(kk) (*(const GAS u32x4*)((const GAS unsigned char*)(VTg + (size_t)(kk) * 4096) + goff))
    const u32x4 zz = (u32x4){0u, 0u, 0u, 0u};
    u32x4 kr[D], vr[D];
#pragma unroll
    for (int s = 0; s < D; ++s) { kr[s] = zz; vr[s] = zz; if (s < kb_hi) { kr[s] = S2_LDK(s); vr[s] = S2_LDV(s); } }
    *(LAS u32x4*)(Kb0 + soff) = kr[0]; *(LAS u32x4*)(Vb0 + soff) = vr[0];
    if (D < kb_hi) { kr[0] = S2_LDK(D); vr[0] = S2_LDV(D); }
    A2_BAR();
    for (int kb4 = 0; kb4 < kb_hi; kb4 += D) {
#pragma unroll
        for (int s = 0; s < D; ++s) {
            const int k = kb4 + s;
            if (k < kb_hi) {
                const int s1 = (s + 1) % D;
                if (k + 1 < kb_hi) { *(LAS u32x4*)(Kb0 + ((s + 1) & 1) * KBUF + soff) = kr[s1]; *(LAS u32x4*)(Vb0 + ((s + 1) & 1) * KBUF + soff) = vr[s1]; }
                if (k + 1 + D < kb_hi) { kr[s1] = S2_LDK(k + 1 + D); vr[s1] = S2_LDV(k + 1 + D); }
                sel_block(k, Kb0 + (s & 1) * KBUF, Vb0 + (s & 1) * KBUF, t_base, lds, o, l, lane, wave);
                A2_BAR();
            }
        }
    }
#undef S2_LDK
#undef S2_LDV
#pragma unroll
    for (int q = 0; q < 8; ++q)
#pragma unroll
        for (int i = 0; i < 4; ++i) {
            float ls = row16_sum(l[q][i]); ls += __shfl_xor(ls, 16); ls += __shfl_xor(ls, 32);
            const float sc = gate0[(size_t)q * 48 + i * 3 + 1] * gscale / ls;
            stq[(q * 4 + i) * 64 + 16 * rq + n] += o[q][i] * sc;
        }
}

__device__ __forceinline__ void attn_phase(const Params& p, ldsp_t lds, int tid, int lane, int wave) {
    unsigned char* ws = launder_ptr(p.ws);
    gbf_t Qr = (gbf_t)(ws + R1_Q);
    const GAS float* Gt = (const GAS float*)(ws + R1_GT);
    GAS bf16* O = (GAS bf16*)(ws + WS_R2);
    LAS float* imp = (LAS float*)(lds + A2_IMP);
    LAS unsigned* selm = (LAS unsigned*)(lds + A2_SEL);
    const int n = lane & 15, rq = lane >> 4;
    GAS unsigned* qctr = (GAS unsigned*)ws;
    volatile LAS int* ubox = (volatile LAS int*)(lds + A2_SEL + 2048);
    for (;;) {
        if (tid == 0) ubox[0] = (int)__hip_atomic_fetch_add(qctr, 1u, __ATOMIC_RELAXED, __HIP_MEMORY_SCOPE_AGENT);
        __syncthreads();
        const int u = __builtin_amdgcn_readfirstlane(ubox[0]);
        __syncthreads();
        if (u >= 2048) break;
        const int bg = u & 7; const int qb = 255 - (u >> 3);
        const int b = bg >> 2, g = bg & 3; const int t_base = 64 * qb; const int cur = qb;
        gbf_t KS = (gbf_t)(ws + R1_KS) + (size_t)bg * SEQ * 64;
        gbf_t VST = (gbf_t)(ws + R1_VST) + (size_t)bg * SEQ * 64;
        gbf_t KW = (gbf_t)(ws + R1_KW) + (size_t)bg * SEQ * 64;
        gbf_t VWT = (gbf_t)(ws + R1_VWT) + (size_t)bg * SEQ * 64;
        gbf_t KCMP = (gbf_t)(ws + R1_KCMP) + (size_t)bg * 1024 * 64;
        gbf_t VCMPT = (gbf_t)(ws + R1_VCMPT) + (size_t)bg * 1024 * 64;
        const GAS float* gate0 = Gt + (size_t)(b * SEQ + t_base + 8 * wave) * 48 + g * 12;
        { LAS u32x4* z = (LAS u32x4*)imp + wave * 512; const u32x4 zz = (u32x4){0u, 0u, 0u, 0u};
#pragma unroll
          for (int k = 0; k < 8; ++k) z[lane + 64 * k] = zz; }
        bf16x8 qA[2][2];
#pragma unroll
        for (int T = 0; T < 2; ++T) { gbf_t qp = Qr + (size_t)(b * SEQ + t_base + 8 * wave + 4 * T + (n >> 2)) * 1024 + (g * 4 + (n & 3)) * 64 + 8 * rq;
            qA[T][0] = *(const GAS bf16x8*)qp; qA[T][1] = *(const GAS bf16x8*)(qp + 32); }
        f32x4 oacc[2][4];
        LAS float* stq = imp + wave * 2048;
        { const int nv = 4 * qb + 3; const int nkb = (nv + 63) >> 6;
          attn_branch<0>(KCMP, VCMPT, 0, nkb, t_base, lds, qA, oacc, gate0, 0, 1.0f, tid, lane, wave);
          for (int rep_ = 1; rep_ < REP_CMP; ++rep_) { f32x4 o2[2][4]; attn_branch<0>(KCMP, VCMPT, 0, nkb, t_base, lds, qA, o2, gate0, 0, 0.0f, tid, lane, wave);
#pragma unroll
              for (int T = 0; T < 2; ++T)
#pragma unroll
                  for (int dt = 0; dt < 4; ++dt) oacc[T][dt] += o2[T][dt]; } }
#pragma unroll 1
        for (int qq_ = 0; qq_ < 2 * REP_TOPK; ++qq_) { const int qq = (qq_ & 1) * 4;
            unsigned kk[4][4], word[4];
#pragma unroll
            for (int e = 0; e < 4; ++e) { const int j = lane + 64 * e; const bool valid = (j >= 1) && (j <= cur - 2);
#pragma unroll
                for (int x = 0; x < 4; ++x) { float v = 0.f; if (valid) v = imp[(8 * wave + qq + x) * 256 + j];
                    kk[x][e] = valid ? ((__builtin_bit_cast(unsigned, v) & ~0xFFu) | (unsigned)(255 - j)) : 0u; } }
            unsigned w0 = 0u;
            if (lane == 0) w0 |= 1u;
            if (cur >= 1 && lane == (cur >> 5)) w0 |= 1u << (cur & 31);
            if (cur >= 2 && lane == ((cur - 1) >> 5)) w0 |= 1u << ((cur - 1) & 31);
#pragma unroll
            for (int x = 0; x < 4; ++x) word[x] = w0;
            const int ns0 = cur >= 2 ? 3 : (cur >= 1 ? 2 : 1);
            const int need = 16 - ns0;
            for (int it = 0; it < need; ++it) {
                unsigned wm[4];
#pragma unroll
                for (int x = 0; x < 4; ++x) wm[x] = wave_max_u32(umax2(umax2(kk[x][0], kk[x][1]), umax2(kk[x][2], kk[x][3])));
                if (wm[0] == 0u) break;
#pragma unroll
                for (int x = 0; x < 4; ++x) {
                    const int j = 255 - (int)(wm[x] & 0xFFu);
                    if (lane == (j >> 5)) word[x] |= 1u << (j & 31);
                    const bool mine = (lane == (j & 63));
#pragma unroll
                    for (int e = 0; e < 4; ++e) if (mine && e == (j >> 6)) kk[x][e] = 0u;
                }
            }
            if (lane < 8) {
#pragma unroll
                for (int x = 0; x < 4; ++x) selm[(8 * wave + qq + x) * 8 + lane] = word[x];
            }
        }
        asm volatile("s_waitcnt lgkmcnt(0)" ::: "memory");
#pragma unroll
        for (int T = 0; T < 2; ++T)
#pragma unroll
            for (int dt = 0; dt < 4; ++dt)
#pragma unroll
                for (int i = 0; i < 4; ++i) stq[((4 * T + rq) * 4 + i) * 64 + 16 * dt + n] = oacc[T][dt][i];
        { int lo = t_base - 511; if (lo < 0) lo = 0;
          for (int rep_ = 0; rep_ < REP_WIN; ++rep_) {
              attn_branch<1>(KW, VWT, lo >> 6, cur + 1, t_base, lds, qA, oacc, gate0, 2, 1.0f / REP_WIN, tid, lane, wave);
#pragma unroll
              for (int T = 0; T < 2; ++T)
#pragma unroll
                  for (int dt = 0; dt < 4; ++dt)
#pragma unroll
                      for (int i = 0; i < 4; ++i) stq[((4 * T + rq) * 4 + i) * 64 + 16 * dt + n] += oacc[T][dt][i];
          } }
        asm volatile("s_waitcnt lgkmcnt(0)" ::: "memory");
#if OLD_SEL
        { attn_branch<2>(KS, VST, 0, cur + 1, t_base, lds, qA, oacc, gate0, 1, 1.0f, tid, lane, wave);
#pragma unroll
          for (int T = 0; T < 2; ++T)
#pragma unroll
              for (int dt = 0; dt < 4; ++dt)
#pragma unroll
                  for (int i = 0; i < 4; ++i) stq[((4 * T + rq) * 4 + i) * 64 + 16 * dt + n] += oacc[T][dt][i]; }
#else
        for (int rep_ = 0; rep_ < REP_SEL; ++rep_) sel_branch(KS, VST, cur + 1, t_base, lds, gate0, 1.0f / REP_SEL, stq, tid, lane, wave);
#endif
        asm volatile("s_waitcnt lgkmcnt(0)" ::: "memory");
#pragma unroll
        for (int q = 0; q < 8; ++q) {
            const f32x4 v = *(const LAS f32x4*)(stq + q * 256 + 4 * lane);
            u32x2 w; w.x = pk2(v[0], v[1]); w.y = pk2(v[2], v[3]);
            *(GAS u32x2*)(O + (size_t)(b * SEQ + t_base + 8 * wave + q) * 1024 + g * 256 + 4 * lane) = w;
        }
    }
}

#define XB_TMO      128
#define XB_XCNT(j)  (256  + 64 * (j))
#define XB_XSUB(j)  (1280 + 64 * (j))
#define XB_XGEN(j)  (2304 + 64 * (j))
#define XB_TOP      3328
#define XB_TOPGEN   3392
#define XCD_BAR_WORDS 3456
#define XB_SPIN_CAP (1u << 18)

__device__ __forceinline__ unsigned xb_ld(unsigned* p)              { return __hip_atomic_load(p, __ATOMIC_RELAXED, __HIP_MEMORY_SCOPE_AGENT); }
__device__ __forceinline__ unsigned xb_add(unsigned* p, unsigned v) { return __hip_atomic_fetch_add(p, v, __ATOMIC_RELAXED, __HIP_MEMORY_SCOPE_AGENT); }
__device__ __forceinline__ unsigned xb_xcc_id() { return (unsigned)__builtin_amdgcn_s_getreg((3 << 11) | 20) & 0xFu; }
#define XB_SPIN(cond, bar) do { unsigned _sp = 0; while (cond) { __builtin_amdgcn_s_sleep(1); \
    if ((++_sp & 255u) == 0u) { if (xb_ld(&(bar)[XB_TMO])) break; if (_sp > XB_SPIN_CAP) { atomicAdd(&(bar)[XB_TMO], 1u); break; } } } } while (0)

struct XcdBarrier {
    unsigned* bar; unsigned x;
    volatile LAS unsigned* st;
};

__device__ __forceinline__ XcdBarrier xcd_barrier_post(unsigned* bar, volatile LAS unsigned* st) {
    XcdBarrier b; b.bar = bar; b.x = xb_xcc_id(); b.st = st;
    if (threadIdx.x == 0) (void)xb_add(&bar[XB_XCNT(b.x)], 1u);
    return b;
}
__device__ __forceinline__ void xcd_barrier_complete(unsigned* bar, unsigned x, unsigned& nloc, unsigned& nx) {
    const unsigned G = gridDim.x * gridDim.y * gridDim.z;
    unsigned sum, cnt, mine, sp = 0u;
    for (;;) {
        sum = 0u; cnt = 0u; mine = 0u;
#pragma unroll
        for (unsigned j = 0; j < 16; ++j) { const unsigned c = xb_ld(&bar[XB_XCNT(j)]); sum += c; cnt += (c > 0u) ? 1u : 0u; mine = (j == x) ? c : mine; }
        if (sum == G) break;
        __builtin_amdgcn_s_sleep(1);
        if ((++sp & 255u) == 0u) { if (xb_ld(&bar[XB_TMO])) break; if (sp > XB_SPIN_CAP) { atomicAdd(&bar[XB_TMO], 1u); break; } }
    }
    nloc = mine > 0u ? mine : 1u; nx = cnt > 0u ? cnt : 1u;
}

__device__ __forceinline__ void xcd_barrier(const XcdBarrier& b) {
    asm volatile("s_waitcnt vmcnt(0)" ::: "memory");
    __syncthreads();
    if (threadIdx.x == 0) {
        unsigned* bar = b.bar;
        __builtin_amdgcn_s_waitcnt(0);
        unsigned nloc = b.st[0], nx = b.st[1];
        if (nloc == 0u) { xcd_barrier_complete(bar, b.x, nloc, nx); b.st[0] = nloc; b.st[1] = nx; }
        const unsigned old = xb_add(&bar[XB_XSUB(b.x)], 1u);
        const unsigned gen = old / nloc;
        if (old + 1u == (gen + 1u) * nloc) {
            __builtin_amdgcn_fence(__ATOMIC_RELEASE, "agent");
            asm volatile("s_waitcnt vmcnt(0)" ::: "memory");
            const unsigned og = xb_add(&bar[XB_TOP], 1u);
            const unsigned tg = og / nx;
            if (og + 1u == (tg + 1u) * nx) xb_add(&bar[XB_TOPGEN], 1u);
            else XB_SPIN(xb_ld(&bar[XB_TOPGEN]) == tg, bar);
            __builtin_amdgcn_fence(__ATOMIC_ACQUIRE, "agent");
            xb_add(&bar[XB_XGEN(b.x)], 1u);
            asm volatile("s_waitcnt vmcnt(0)" ::: "memory");
        } else {
            XB_SPIN(xb_ld(&bar[XB_XGEN(b.x)]) == gen, bar);
            __builtin_amdgcn_fence(__ATOMIC_ACQUIRE, "agent");
            asm volatile("s_waitcnt vmcnt(0)" ::: "memory");
        }
    }
    __syncthreads();
}

constexpr size_t WS_BAR = 16384;
constexpr int LDS_BARST = 156160;

__global__ void __launch_bounds__(512, 2) mega(Params p) {
    extern __shared__ __attribute__((aligned(16))) unsigned char lds[];
    cg::grid_group grid = cg::this_grid();
    PG8_LAS unsigned char* glds = (PG8_LAS unsigned char*)lds;
    const int G = gridDim.x, c = blockIdx.x;
    volatile LAS unsigned* barst = (volatile LAS unsigned*)(glds + LDS_BARST);
    if (threadIdx.x < 2) barst[threadIdx.x] = 0u;
    __syncthreads();
    XcdBarrier xbar; xbar.bar = (unsigned*)(p.ws + WS_BAR); xbar.x = 0; xbar.st = barst;
    for (int st = 0; st < 25; ++st) {
        int tid_l = threadIdx.x; asm volatile("" : "+v"(tid_l));
        const int tid = tid_l, lane = tid & 63, wave = __builtin_amdgcn_readfirstlane(tid >> 6);
        unsigned char* ws;
        { const unsigned long long wsv = (unsigned long long)p.ws; unsigned lo = (unsigned)wsv, hi = (unsigned)(wsv >> 32); asm volatile("" : "+v"(lo), "+v"(hi));
          lo = __builtin_amdgcn_readfirstlane(lo); hi = __builtin_amdgcn_readfirstlane(hi); ws = (unsigned char*)(((unsigned long long)hi << 32) | lo); }
        bf16* XB = (bf16*)(ws + WS_XB);
        int kind, a = 0;
        switch (st) {
            case 0: kind = 0; break;
            case 1: kind = 1; a = 0; break;  case 2: kind = 2; a = 0; break;  case 3: kind = 3; a = 3; break;
            case 4: kind = 4; a = 0; break;  case 5: kind = 5; a = 0; break;  case 6: kind = 6; a = 0; break;
            case 7: kind = 4; a = 1; break;  case 8: kind = 5; a = 1; break;  case 9: kind = 6; a = 1; break;
            case 10: kind = 3; a = 11; break;
            case 11: kind = 1; a = 1; break; case 12: kind = 2; a = 1; break; case 13: kind = 3; a = 15; break;
            case 14: kind = 1; a = 2; break; case 15: kind = 2; a = 2; break; case 16: kind = 3; a = 19; break;
            case 17: kind = 7; break; case 18: kind = 8; break; case 19: kind = 9; break; case 20: kind = 10; break;
            case 21: kind = 3; a = 29; break;
            case 22: kind = 1; a = 3; break; case 23: kind = 2; a = 3; break; default: kind = 3; a = 33; break;
        }
        if (kind == 0) {
            for (int r_ = 0; r_ < REP_PRO; ++r_) prologue(p, lds, tid, lane, wave);
        } else if (kind == 1) {
            pg8::Gemm g{XB, (const bf16*)(ws + WS_W + a * W_FFN_STRIDE), MTOK, 2 * DFF, DM}; pg8::StaticOrder S; S.init(MTOK, 2 * DFF, G, c);
            pg8::EpiSwiglu E{(bf16*)(ws + R1_H), DFF};
            for (int r_ = 0; r_ < REP_UP; ++r_) pg8::gemm_phase<pg8::EpiSwiglu, pg8::StaticOrder, true, true>(glds, g, S, E);
        } else if (kind == 2 || kind == 6 || kind == 10) {
            const bf16* A_; const bf16* B_; int M_, K_; const float* R_; float* Y_; float sc_;
            if (kind == 2) { A_ = (const bf16*)(ws + R1_H); B_ = (const bf16*)(ws + WS_W + a * W_FFN_STRIDE + W_FFN_W2); M_ = MTOK; K_ = DFF; R_ = (a == 0 ? kin(0) : (const float*)p.out); Y_ = p.out; sc_ = 0.5f; }
            else if (kind == 6) { A_ = (const bf16*)(ws + WS_R2); B_ = (const bf16*)(ws + WS_GMO); M_ = 16384; K_ = GMW; Y_ = p.out + (size_t)a * 16384 * DM; R_ = Y_; sc_ = 1.0f; }
            else { A_ = (const bf16*)(ws + WS_R2); B_ = (const bf16*)(ws + WS_NSO); M_ = MTOK; K_ = DM; R_ = p.out; Y_ = p.out; sc_ = 1.0f; }
            pg8::Gemm g{A_, B_, M_, DM, K_}; pg8::StaticOrder S; S.init(M_, DM, G, c);
            pg8::EpiRes E{kind * 8 + a};
#ifndef NO_K2
            pg8::gemm_phase<pg8::EpiRes, pg8::StaticOrder, true, true>(glds, g, S, E);
#endif
        } else if (kind == 3) {
            if (a == 33) ln_phase<1>((const GAS float*)p.out, (GAS float*)p.out, (GAS bf16*)XB, (GAS float*)(ws + WS_ST), (const GAS float*)kin(a), (const GAS float*)kin(a + 1), lane, wave);
            else for (int r_ = 0; r_ < REP_LN; ++r_) ln_phase<0>((const GAS float*)p.out, (GAS float*)p.out, (GAS bf16*)XB, (GAS float*)(ws + WS_ST), (const GAS float*)kin(a), (const GAS float*)kin(a + 1), lane, wave);
        } else if (kind == 4) {
            pg8::Gemm g{XB + (size_t)a * 16384 * DM, (const bf16*)(ws + WS_GMI), 16384, 2 * GMW, DM}; pg8::StaticOrder S; S.init(16384, 2 * GMW, G, c);
            pg8::EpiGm E{(bf16*)(ws + R1_U), (bf16*)(ws + R1_VT), (float*)(ws + WS_PS)};
            for (int r_ = 0; r_ < REP_GMI; ++r_) pg8::gemm_phase<pg8::EpiGm, pg8::StaticOrder, true, true>(glds, g, S, E);
        } else if (kind == 5) {
            for (int r_ = 0; r_ < REP_GATE; ++r_) gm_gate_phase((const GAS bf16*)(ws + R1_VT), (const GAS bf16*)(ws + R1_U), (GAS bf16*)(ws + WS_R2), (const GAS float*)kin(8), (const GAS float*)kin(9), (const GAS float*)kin(6), (const GAS float*)kin(7), (const GAS float*)(ws + WS_PS), lds, tid, lane, wave);
        } else if (kind == 7) {
            pg8::Gemm g{XB, (const bf16*)(ws + WS_NSI), MTOK, 2816, DM}; pg8::StaticOrder S; S.init(MTOK, 2816, G, c);
            pg8::EpiNsa E{(bf16*)(ws + R1_Q), (bf16*)(ws + R1_KC), (bf16*)(ws + R1_VC), (bf16*)(ws + R1_KS), (bf16*)(ws + R1_VST), (bf16*)(ws + R1_KW), (bf16*)(ws + R1_VWT),
                          (float*)(ws + R1_GT), (const float*)(ws + WS_COS), (const float*)(ws + WS_SIN)};
            for (int r_ = 0; r_ < REP_NSI; ++r_) pg8::gemm_phase<pg8::EpiNsa, pg8::StaticOrder, true, true>(glds, g, S, E);
        } else if (kind == 8) {
            for (int r_ = 0; r_ < REP_CMPR; ++r_) compress_phase(p, lds, tid, lane, wave);
        } else if (kind == 9) {
            for (int rep_ = 0; rep_ < REP_ATTN; ++rep_) {
                if (rep_ > 0) { xcd_barrier(xbar); if (blockIdx.x == 0 && tid == 0) *(GAS unsigned*)ws = 0u; xcd_barrier(xbar); }
                attn_phase(p, (ldsp_t)lds, tid, lane, wave);
            }
        }
        if (st == 0) { grid.sync(); xbar = xcd_barrier_post((unsigned*)(p.ws + WS_BAR), barst); }
        else if (st != 24) { xcd_barrier(xbar); for (int r_ = 1; r_ < REP_SYNC; ++r_) xcd_barrier(xbar); }
    }
}

extern "C" void kernel_launch(void* const* d_in, const int* in_sizes, int n_in, void* d_out, int out_size, void* d_ws, size_t ws_size, hipStream_t stream) {
    static int grid = 0;
    if (grid == 0) {
        if (n_in != 35 || ws_size < WS_END) { fprintf(stderr, "kernel_launch: unexpected n_in %d / ws %zu\n", n_in, ws_size); grid = -1; return; }
        int dev = 0, cus = 0, per_cu = 0;
        hipGetDevice(&dev); hipDeviceGetAttribute(&cus, hipDeviceAttributeMultiprocessorCount, dev);
        hipFuncSetAttribute((const void*)mega, hipFuncAttributeMaxDynamicSharedMemorySize, LDS_BYTES);
        hipOccupancyMaxActiveBlocksPerMultiprocessor(&per_cu, (const void*)mega, 512, LDS_BYTES);
        if (per_cu < 1) per_cu = 1;
        (void)hipGetLastError();
        grid = cus * per_cu;
    }
    if (grid < 0) return;
    Params p{};
    for (int i = 0; i < 35; ++i) p.in[i] = (const float*)d_in[i];
    p.out = (float*)d_out; p.ws = (unsigned char*)d_ws;
    void* args[] = {&p};
    hipError_t e = hipLaunchCooperativeKernel((void*)mega, dim3(grid), dim3(512), args, LDS_BYTES, stream);
    if (e != hipSuccess) fprintf(stderr, "cooperative launch failed: %s (grid %d)\n", hipGetErrorString(e), grid);
}
```

```cpp
#include <hip/hip_runtime.h>
#include <cstdio>
#include <cstdint>
namespace pg8 {
#define PG8_LAS __attribute__((address_space(3)))
typedef unsigned short bf16_t;
typedef short bf16x8 __attribute__((ext_vector_type(8)));
typedef float f32x4 __attribute__((ext_vector_type(4)));
typedef unsigned u32x4 __attribute__((ext_vector_type(4)));
constexpr int BM = 256, BK = 64, HALF = 128, HTB = HALF * BK * 2  , STAGE_BYTES = 8 * HTB, NXCD = 8, WGM = 8;

__host__ __device__ __forceinline__ int lds_byte(int r, int c) { const int st = (r >> 4) * 2 + (c >> 5), rr = r & 15, cc = c & 31, ob = rr * 64 + cc * 2; return st * 1024 + (ob ^ (((ob >> 9) & 1) << 5)); }
__host__ __device__ __forceinline__ void stage_rc(int b, int& R, int& C) { const int st = b / 1024, sb = b % 1024, swz = sb ^ (((sb >> 9) & 1) << 5); R = (st >> 1) * 16 + swz / 64; C = (st & 1) * 32 + (swz % 64) / 2; }
__host__ __device__ __forceinline__ int perm32(int rho) { const int n = rho >> 4, i = rho & 15; return 8 * (i >> 2) + 4 * n + (i & 3); }

struct Unit { int pm, pn; };
struct Gemm { const bf16_t* A; const bf16_t* Bt; int M, N, K; };

struct StaticOrder {
    int nM, nN, nwg, G, c;
    __host__ __device__ void init(int M, int N, int G_, int c_) { nM = M / BM; nN = N / BM; nwg = nM * nN; G = G_; c = c_; }
    __host__ __device__ bool next(int i, Unit& u) const {
        const long L = (long)i * G + c; if (L >= nwg) return false;
        int wgid = (int)L; { const int q = nwg / NXCD, r = nwg % NXCD, xcd = wgid % NXCD, off = wgid / NXCD; wgid = (xcd < r ? xcd * (q + 1) : r * (q + 1) + (xcd - r) * q) + off; }
        const int nig = WGM * nN, gid = wgid / nig, fm = gid * WGM, gsz = (nM - fm) < WGM ? (nM - fm) : WGM;
        u.pm = fm + ((wgid % nig) % gsz); u.pn = (wgid % nig) / gsz; return true;
    }
    __device__ __forceinline__ void a_ready(const Unit&) const {}
    __device__ __forceinline__ void done(const Unit&) const {}
};
__device__ __forceinline__ unsigned cvt_pk_bf16(float lo, float hi) { unsigned r; asm volatile("v_cvt_pk_bf16_f32 %0, %1, %2" : "=v"(r) : "v"(lo), "v"(hi)); return r; }
__device__ __forceinline__ float fast_exp(float x) { return __builtin_amdgcn_exp2f(x * 1.4426950408889634f); }
__device__ __forceinline__ float silu_f(float x) { return x * __builtin_amdgcn_rcpf(1.0f + fast_exp(-x)); }
__device__ __forceinline__ float sigmoid_f(float x) { return __builtin_amdgcn_rcpf(1.0f + fast_exp(-x)); }
__device__ __forceinline__ float gelu_tanh_f(float x) { const float z = 0.7978845608028654f * (x + 0.044715f * x * x * x); return x * __builtin_amdgcn_rcpf(1.0f + fast_exp(-2.0f * z)); }
typedef float f32x2 __attribute__((ext_vector_type(2)));
__device__ __forceinline__ f32x2 silu_mul_pk(f32x2 x, f32x2 u) {
    const f32x2 a = x * (-1.4426950408889634f);
    f32x2 e; e.x = __builtin_amdgcn_exp2f(a.x); e.y = __builtin_amdgcn_exp2f(a.y);
    const f32x2 d = e + 1.0f;
    f32x2 r; r.x = __builtin_amdgcn_rcpf(d.x); r.y = __builtin_amdgcn_rcpf(d.y);
    return (x * r) * u;
}
__device__ __forceinline__ f32x2 gelu_tanh_pk(f32x2 x) {
    const f32x2 x2 = x * x;
    const f32x2 a = x * (x2 * (-0.10294324f) + (-2.3022082f));
    f32x2 e; e.x = __builtin_amdgcn_exp2f(a.x); e.y = __builtin_amdgcn_exp2f(a.y);
    const f32x2 d = e + 1.0f;
    f32x2 r; r.x = __builtin_amdgcn_rcpf(d.x); r.y = __builtin_amdgcn_rcpf(d.y);
    return x * r;
}
__host__ __device__ __forceinline__ int kpos64(int l) { return (l & 32) | (((l >> 2) & 3) << 3) | ((l & 3) << 1) | ((l >> 4) & 1); }
__device__ __forceinline__ bf16_t bf16_1(float x) { return (bf16_t)(cvt_pk_bf16(x, x) & 0xffffu); }
typedef unsigned u32x2 __attribute__((ext_vector_type(2)));

struct EpiSwiglu {
    static constexpr bool PERM = true, AFTER_DRAIN = false;
    bf16_t* H; int ldh;
    __device__ __forceinline__ void operator()(const f32x4 (&acc)[2][2][4][2], const Unit& u, int wr, int wc, int fr, int fq) const {
        const int row0 = u.pm * BM + wr * 64 + fr; const int col0 = u.pn * HALF + wc * 32 + 8 * fq;
#pragma unroll
        for (int ai = 0; ai < 2; ++ai)
#pragma unroll
            for (int m = 0; m < 4; ++m) {
                bf16_t* p = H + (size_t)(row0 + ai * HALF + m * 16) * ldh + col0;
                const f32x4 g0 = acc[ai][0][m][0], g1 = acc[ai][0][m][1], u0 = acc[ai][1][m][0], u1 = acc[ai][1][m][1];
                u32x4 w;
                { const f32x2 a = silu_mul_pk((f32x2){g0[0], g0[1]}, (f32x2){u0[0], u0[1]}), b = silu_mul_pk((f32x2){g0[2], g0[3]}, (f32x2){u0[2], u0[3]});
                  const f32x2 c = silu_mul_pk((f32x2){g1[0], g1[1]}, (f32x2){u1[0], u1[1]}), d = silu_mul_pk((f32x2){g1[2], g1[3]}, (f32x2){u1[2], u1[3]});
                  w.x = cvt_pk_bf16(a.x, a.y); w.y = cvt_pk_bf16(b.x, b.y); w.z = cvt_pk_bf16(c.x, c.y); w.w = cvt_pk_bf16(d.x, d.y); }
                *(u32x4*)p = w;
            }
    }
};

struct EpiRes {
    static constexpr bool PERM = false, AFTER_DRAIN = false;
    int code;
    __device__ __forceinline__ void operator()(const f32x4 (&acc)[2][2][4][2], const Unit& u, int wr, int wc, int fr, int fq) const {
        typedef float f32x2e __attribute__((ext_vector_type(2)));
        typedef const float* cfp_t;
        const __attribute__((address_space(4))) cfp_t* ka = (const __attribute__((address_space(4))) cfp_t*)__builtin_amdgcn_kernarg_segment_ptr();
        const int kind = code >> 3, a = code & 7;
        float* out = (float*)ka[35]; const unsigned char* ws = (const unsigned char*)ka[36];
        const float* R; float* Y; float s; int lnq, strow0;
        if (kind == 2) { R = a == 0 ? ka[0] : (const float*)out; Y = out; s = 0.5f; lnq = a == 0 ? -1 : a == 1 ? 11 : a == 2 ? 15 : 29; strow0 = 0; }
        else if (kind == 6) { Y = out + (size_t)a * 16384 * 1024; R = Y; s = 1.0f; lnq = 3; strow0 = a * 16384; }
        else { R = out; Y = out; s = 1.0f; lnq = 19; strow0 = 0; }
        const float alpha = 1.4142135623730951f;
        const bool use_ln = lnq >= 0;
        const float* st = (const float*)(ws + (5u * 1048576u + 524288u));
        const float* lg = ka[use_ln ? lnq : 3]; const float* lb = ka[use_ln ? lnq + 1 : 4];
        const int row0 = u.pm * BM + wr * 64 + fr; const int col0 = u.pn * BM + wc * 32 + 4 * fq;
#pragma unroll
        for (int ai = 0; ai < 2; ++ai)
#pragma unroll
            for (int m = 0; m < 4; ++m) {
                const int row = row0 + ai * HALF + m * 16;
                f32x2e ms = (f32x2e){0.f, 1.f};
                if (use_ln) ms = *(const f32x2e*)(st + (size_t)(strow0 + row) * 2);
#pragma unroll
                for (int bj = 0; bj < 2; ++bj)
#pragma unroll
                    for (int n = 0; n < 2; ++n) {
                        const int col = col0 + bj * HALF + n * 16;
                        const size_t off = (size_t)row * 1024 + col;
                        f32x4 r = *(const f32x4*)(R + off);
                        if (use_ln) { const f32x4 gv = *(const f32x4*)(lg + col), bv = *(const f32x4*)(lb + col); r = (r - ms.x) * ms.y * gv + bv; }
                        *(f32x4*)(Y + off) = r * alpha + acc[ai][bj][m][n] * s;
                    }
                asm volatile("" ::: "memory");
            }
    }
};

struct EpiGm {
    static constexpr bool PERM = false, AFTER_DRAIN = false;
    bf16_t* U; bf16_t* VT; float* PS;
    __device__ __forceinline__ void operator()(const f32x4 (&acc)[2][2][4][2], const Unit& u, int wr, int wc, int fr, int fq) const {
        const int row0 = u.pm * BM + wr * 64 + fr;
        if (u.pn < 12) {
            const int col0 = u.pn * BM + wc * 32 + 4 * fq;
#pragma unroll
            for (int ai = 0; ai < 2; ++ai)
#pragma unroll
                for (int m = 0; m < 4; ++m)
#pragma unroll
                    for (int bj = 0; bj < 2; ++bj)
#pragma unroll
                        for (int n = 0; n < 2; ++n) {
                            const f32x4 v = acc[ai][bj][m][n];
                            const f32x2 ga = gelu_tanh_pk((f32x2){v[0], v[1]}), gb = gelu_tanh_pk((f32x2){v[2], v[3]});
                            u32x2 w; w.x = cvt_pk_bf16(ga.x, ga.y); w.y = cvt_pk_bf16(gb.x, gb.y);
                            *(u32x2*)(U + (size_t)(row0 + ai * HALF + m * 16) * 3072 + col0 + bj * HALF + n * 16) = w;
                            if (bj == 1 && n == 1) asm volatile("" ::: "memory");
                        }
        } else {
            const int col0 = (u.pn - 12) * BM + wc * 32 + 4 * fq;
#pragma unroll
            for (int ai = 0; ai < 2; ++ai)
#pragma unroll
                for (int m = 0; m < 4; ++m) {
                    const int row = row0 + ai * HALF + m * 16; const int ch = row >> 7, s = row & 127;
                    bf16_t* base = VT + (size_t)ch * 3072 * 128 + s;
                    float ssum = 0.f, qsum = 0.f;
#pragma unroll
                    for (int bj = 0; bj < 2; ++bj)
#pragma unroll
                        for (int n = 0; n < 2; ++n) {
                            const f32x4 v = acc[ai][bj][m][n]; const int c = col0 + bj * HALF + n * 16;
                            const f32x2 ga = gelu_tanh_pk((f32x2){v[0], v[1]}), gb = gelu_tanh_pk((f32x2){v[2], v[3]}); const float gq[4] = {ga.x, ga.y, gb.x, gb.y};
#pragma unroll
                            for (int i = 0; i < 4; ++i) { const float gv = gq[i]; ssum += gv; qsum += gv * gv; base[(size_t)(c + i) * 128] = bf16_1(gv); }
                            asm volatile("" ::: "memory");
                        }
                    ssum += __shfl_xor(ssum, 16); ssum += __shfl_xor(ssum, 32); qsum += __shfl_xor(qsum, 16); qsum += __shfl_xor(qsum, 32);
                    if (fq == 0) { f32x2 pq; pq.x = ssum; pq.y = qsum; *(f32x2*)(PS + ((size_t)row * 48 + (u.pn - 12) * 4 + wc) * 2) = pq; }
                }
        }
    }
};

struct EpiNsa {
    static constexpr bool PERM = false, AFTER_DRAIN = false;
    bf16_t *Qr, *KC, *VC, *KS, *VST, *KW, *VWT; float* Gt; const float* cosT; const float* sinT;
    __device__ __forceinline__ void operator()(const f32x4 (&acc)[2][2][4][2], const Unit& u, int wr, int wc, int fr, int fq) const {
        const int row0 = u.pm * BM + wr * 64 + fr; const int pn = u.pn;
#pragma unroll
        for (int ai = 0; ai < 2; ++ai)
#pragma unroll
            for (int m = 0; m < 4; ++m) {
                const int row = row0 + ai * HALF + m * 16; const int b = row >> 14, t = row & 16383;
                if (pn < 6) {
#pragma unroll
                    for (int n = 0; n < 2; ++n) {
                        const int dl = 16 * n + 4 * fq;
                        const f32x4 cs = *(const f32x4*)(cosT + (size_t)t * 32 + dl), sn = *(const f32x4*)(sinT + (size_t)t * 32 + dl);
                        const f32x4 x1 = acc[ai][0][m][n], x2 = acc[ai][1][m][n];
                        f32x4 y1 = x1 * cs - x2 * sn, y2 = x2 * cs + x1 * sn;
                        bf16_t* dst;
                        if (pn < 4) { y1 = y1 * 0.18033688011112042f; y2 = y2 * 0.18033688011112042f;     dst = Qr + (size_t)row * 1024 + (4 * pn + wc) * 64 + dl; }
                        else { dst = (pn == 4 ? KS : KW) + ((size_t)(b * 4 + wc) * 16384 + t) * 64 + dl; }
                        u32x2 w1, w2; w1.x = cvt_pk_bf16(y1[0], y1[1]); w1.y = cvt_pk_bf16(y1[2], y1[3]); w2.x = cvt_pk_bf16(y2[0], y2[1]); w2.y = cvt_pk_bf16(y2[2], y2[3]);
                        *(u32x2*)dst = w1; *(u32x2*)(dst + 32) = w2;
                    }
                } else if (pn < 8) {
                    bf16_t* base = (pn == 6 ? KC : VC) + (size_t)row * 256 + wc * 32 + 4 * fq;
#pragma unroll
                    for (int bj = 0; bj < 2; ++bj)
#pragma unroll
                        for (int n = 0; n < 2; ++n) { const f32x4 v = acc[ai][bj][m][n]; u32x2 w; w.x = cvt_pk_bf16(v[0], v[1]); w.y = cvt_pk_bf16(v[2], v[3]); *(u32x2*)(base + bj * HALF + n * 16) = w; }
                } else if (pn < 10) {
                    bf16_t* base = (pn == 8 ? VST : VWT);
#pragma unroll
                    for (int bj = 0; bj < 2; ++bj)
#pragma unroll
                        for (int n = 0; n < 2; ++n) {
                            const f32x4 v = acc[ai][bj][m][n]; const int col = bj * HALF + wc * 32 + n * 16 + 4 * fq;
                            const int g = col >> 6, d = col & 63;
                            bf16_t* p = base + ((((size_t)(b * 4 + g)) * 256 + (t >> 6)) * 64 + d) * 64 + kpos64(t & 63);
#pragma unroll
                            for (int i = 0; i < 4; ++i) p[i * 64] = bf16_1(v[i]);
                        }
                } else {
#pragma unroll
                    for (int n = 0; n < 2; ++n) {
                        const f32x4 v = acc[ai][0][m][n]; const int col = wc * 32 + n * 16 + 4 * fq;
                        if (col < 48) { f32x4 o; o[0] = sigmoid_f(v[0]); o[1] = sigmoid_f(v[1]); o[2] = sigmoid_f(v[2]); o[3] = sigmoid_f(v[3]); *(f32x4*)(Gt + (size_t)row * 48 + col) = o; }
                    }
                }
                asm volatile("" ::: "memory");
            }
    }
};
template <class Epi, class Sched, bool ALIGN_EPI = false, bool SP2 = false>
__device__ __forceinline__ void gemm_phase(PG8_LAS unsigned char* lds, const Gemm g, const Sched& S, const Epi& E) {
    int tid_l = threadIdx.x; asm volatile("" : "+v"(tid_l));
    const int tid = tid_l, wid = __builtin_amdgcn_readfirstlane(tid >> 6), lane = tid & 63, wr = wid >> 2, wc = wid & 3, fr = lane & 15, fq = lane >> 4;
    const int K = g.K, nt = K / BK;
    unsigned voffA[2], voffB[2];
#pragma unroll
    for (int i = 0; i < 2; ++i) { int R, C; stage_rc(tid * 16 + i * 8192, R, C); const int Rb = Epi::PERM ? ((R & ~31) + perm32(R & 31)) : R;
        voffA[i] = (unsigned)(R * K + C) * 2u; voffB[i] = (unsigned)(Rb * K + C) * 2u; }
    const size_t kstep = (size_t)(BK * 2);
    const size_t hstep = (size_t)HALF * K * 2;
    const size_t tstep = 2 * hstep;
    const unsigned ldsw = (unsigned)wid * 1024u;
    const int aoff = lds_byte(wr * 64 + fr, fq * 8), boff = lds_byte(wc * 32 + fr, fq * 8);
#define PG8_SA(b, h) (((b) * 2 + (h)) * HTB)
#define PG8_SB(b, h) ((4 + (b) * 2 + (h)) * HTB)
#define PG8_STAGE(bufoff, gbase, voff) do { _Pragma("unroll") for (int _i = 0; _i < 2; ++_i) \
        __builtin_amdgcn_global_load_lds((const unsigned*)((const char*)(gbase) + (voff)[_i]), (PG8_LAS unsigned*)(lds + (bufoff) + ldsw + _i * 8192), 16, 0, 0); } while (0)
#define PG8_LDA(dst, b, h) do { _Pragma("unroll") for (int m = 0; m < 4; ++m) _Pragma("unroll") for (int k = 0; k < 2; ++k) dst[m][k] = *(const PG8_LAS bf16x8*)(lds + PG8_SA(b, h) + aoff + m * 2048 + k * 1024); } while (0)
#define PG8_LDB(dst, b, h) do { _Pragma("unroll") for (int n = 0; n < 2; ++n) _Pragma("unroll") for (int k = 0; k < 2; ++k) dst[n][k] = *(const PG8_LAS bf16x8*)(lds + PG8_SB(b, h) + boff + n * 2048 + k * 1024); } while (0)
#define PG8_MMA(ai, bj, At, Bt) do { __builtin_amdgcn_s_setprio(1); _Pragma("unroll") for (int m = 0; m < 4; ++m) _Pragma("unroll") for (int n = 0; n < 2; ++n) _Pragma("unroll") for (int k = 0; k < 2; ++k) \
        acc[ai][bj][m][n] = __builtin_amdgcn_mfma_f32_16x16x32_bf16(Bt[n][k], At[m][k], acc[ai][bj][m][n], 0, 0, 0); __builtin_amdgcn_s_setprio(0); } while (0)
#define PG8_WAIT_V(n) asm volatile("s_waitcnt vmcnt(" #n ")" ::: "memory")
#define PG8_WAIT_L(n) asm volatile("s_waitcnt lgkmcnt(" #n ")" ::: "memory")
#define PG8_BAR __builtin_amdgcn_s_barrier()
#define PG8_SCHED __builtin_amdgcn_sched_barrier(0)
    Unit cur, nxt; int ui = 0;
    if (!S.next(0, cur)) return;
    f32x4 acc[2][2][4][2];
#pragma unroll
    for (int a = 0; a < 2; ++a)
#pragma unroll
        for (int b = 0; b < 2; ++b)
#pragma unroll
            for (int m = 0; m < 4; ++m)
#pragma unroll
                for (int n = 0; n < 2; ++n) acc[a][b][m][n] = (f32x4){0.f, 0.f, 0.f, 0.f};
    bf16x8 At[4][2], B0[2][2], B1[2][2];
    const char* cA = (const char*)g.A + (size_t)cur.pm * tstep; const char* cB = (const char*)g.Bt + (size_t)cur.pn * tstep;
    S.a_ready(cur);
    if constexpr (SP2) {
        PG8_STAGE(PG8_SB(0, 0), cB, voffB); PG8_STAGE(PG8_SB(0, 1), cB + hstep, voffB); PG8_STAGE(PG8_SA(0, 0), cA, voffA); PG8_STAGE(PG8_SA(0, 1), cA + hstep, voffA);
        if (wr == 1) PG8_BAR;
        PG8_WAIT_V(2); PG8_BAR;
        PG8_STAGE(PG8_SB(1, 0), cB + kstep, voffB); PG8_STAGE(PG8_SA(1, 0), cA + kstep, voffA); PG8_STAGE(PG8_SB(1, 1), cB + hstep + kstep, voffB);
        PG8_WAIT_V(6); PG8_BAR;
    } else {
        PG8_STAGE(PG8_SB(0, 0), cB, voffB); PG8_STAGE(PG8_SA(0, 0), cA, voffA); PG8_STAGE(PG8_SB(0, 1), cB + hstep, voffB); PG8_STAGE(PG8_SA(0, 1), cA + hstep, voffA);
        if (wr == 1) PG8_BAR;
        PG8_WAIT_V(4); PG8_BAR;
        PG8_STAGE(PG8_SB(1, 0), cB + kstep, voffB); PG8_STAGE(PG8_SA(1, 0), cA + kstep, voffA); PG8_STAGE(PG8_SB(1, 1), cB + hstep + kstep, voffB);
        PG8_WAIT_V(6); PG8_BAR;
    }
    for (;;) {
        const bool has_next = S.next(ui + 1, nxt);
        const char* nA = has_next ? (const char*)g.A + (size_t)nxt.pm * tstep : cA; const char* nB = has_next ? (const char*)g.Bt + (size_t)nxt.pn * tstep : cB;
        for (int t = 0; t < nt; t += 2) {
            const bool last = (t == nt - 2);
            const char* a1 = cA + (size_t)(t + 1) * kstep;
            const char* a2 = last ? nA : cA + (size_t)(t + 2) * kstep; const char* b2 = last ? nB : cB + (size_t)(t + 2) * kstep;
            const char* a3 = a2 + kstep; const char* b3 = b2 + kstep;
            if (last && has_next) S.a_ready(nxt);
            if constexpr (SP2) {
            PG8_LDB(B0, 0, 0); PG8_LDB(B1, 0, 1); PG8_SCHED; PG8_LDA(At, 0, 0); PG8_STAGE(PG8_SA(1, 1), a1 + hstep, voffA);
            PG8_WAIT_V(8); PG8_WAIT_L(0); PG8_BAR; PG8_MMA(0, 0, At, B0); PG8_MMA(0, 1, At, B1); PG8_BAR; PG8_SCHED;
            PG8_LDA(At, 0, 1); PG8_STAGE(PG8_SB(0, 0), b2, voffB); PG8_STAGE(PG8_SB(0, 1), b2 + hstep, voffB); PG8_STAGE(PG8_SA(0, 0), a2, voffA);
            PG8_WAIT_V(8); PG8_WAIT_L(0); PG8_BAR; PG8_MMA(1, 0, At, B0); PG8_MMA(1, 1, At, B1); PG8_BAR; PG8_SCHED;
            PG8_LDB(B0, 1, 0); PG8_LDB(B1, 1, 1); PG8_SCHED; PG8_LDA(At, 1, 0); PG8_STAGE(PG8_SA(0, 1), a2 + hstep, voffA);
            PG8_WAIT_V(8); PG8_WAIT_L(0); PG8_BAR; PG8_MMA(0, 0, At, B0); PG8_MMA(0, 1, At, B1); PG8_BAR; PG8_SCHED;
            PG8_LDA(At, 1, 1); PG8_STAGE(PG8_SB(1, 0), b3, voffB); PG8_STAGE(PG8_SB(1, 1), b3 + hstep, voffB); PG8_STAGE(PG8_SA(1, 0), a3, voffA);
            PG8_WAIT_V(8); PG8_WAIT_L(0); PG8_BAR; PG8_MMA(1, 0, At, B0); PG8_MMA(1, 1, At, B1); PG8_BAR; PG8_SCHED;
            } else {
            PG8_LDB(B0, 0, 0); PG8_SCHED; PG8_LDA(At, 0, 0); PG8_STAGE(PG8_SA(1, 1), a1 + hstep, voffA);
            PG8_WAIT_L(8); PG8_BAR; PG8_WAIT_L(0); PG8_MMA(0, 0, At, B0); PG8_BAR; PG8_SCHED;
            PG8_LDB(B1, 0, 1); PG8_STAGE(PG8_SB(0, 0), b2, voffB);
            PG8_BAR; PG8_WAIT_L(0); PG8_MMA(0, 1, At, B1); PG8_BAR;
            PG8_LDA(At, 0, 1); PG8_STAGE(PG8_SA(0, 0), a2, voffA);
            PG8_BAR; PG8_WAIT_L(0); PG8_MMA(1, 0, At, B0); PG8_BAR; PG8_SCHED;
            PG8_STAGE(PG8_SB(0, 1), b2 + hstep, voffB);
            PG8_WAIT_V(6); PG8_BAR; PG8_MMA(1, 1, At, B1); PG8_BAR;
            PG8_LDB(B0, 1, 0); PG8_SCHED; PG8_LDA(At, 1, 0); PG8_STAGE(PG8_SA(0, 1), a2 + hstep, voffA);
            PG8_WAIT_L(8); PG8_BAR; PG8_WAIT_L(0); PG8_MMA(0, 0, At, B0); PG8_BAR; PG8_SCHED;
            PG8_LDB(B1, 1, 1); PG8_STAGE(PG8_SB(1, 0), b3, voffB);
            PG8_BAR; PG8_WAIT_L(0); PG8_MMA(0, 1, At, B1); PG8_BAR;
            PG8_LDA(At, 1, 1); PG8_STAGE(PG8_SA(1, 0), a3, voffA);
            PG8_BAR; PG8_WAIT_L(0); PG8_MMA(1, 0, At, B0); PG8_BAR; PG8_SCHED;
            PG8_STAGE(PG8_SB(1, 1), b3 + hstep, voffB);
            PG8_WAIT_V(6); PG8_BAR; PG8_MMA(1, 1, At, B1); PG8_BAR;
            }
        }
        if constexpr (ALIGN_EPI) { if (wr == 0) PG8_BAR; }
        if constexpr (!Epi::AFTER_DRAIN) { E(acc, cur, wr, wc, fr, fq); S.done(cur); }
        if (!has_next) break;
#pragma unroll
        for (int a = 0; a < 2; ++a)
#pragma unroll
            for (int b = 0; b < 2; ++b)
#pragma unroll
                for (int m = 0; m < 4; ++m)
#pragma unroll
                    for (int n = 0; n < 2; ++n) acc[a][b][m][n] = (f32x4){0.f, 0.f, 0.f, 0.f};
        cur = nxt; cA = nA; cB = nB; ++ui;
        if constexpr (ALIGN_EPI) { if (wr == 1) PG8_BAR; }
    }
    PG8_WAIT_V(0);
    if constexpr (!ALIGN_EPI) { if (wr == 0) PG8_BAR; }
    PG8_BAR;
    if constexpr (Epi::AFTER_DRAIN) { E.fused(acc, cur, wr, wc, fr, fq, lds, wid, lane); S.done(cur); }
#undef PG8_SA
#undef PG8_SB
#undef PG8_STAGE
#undef PG8_LDA
#undef PG8_LDB
#undef PG8_MMA
#undef PG8_WAIT_V
#undef PG8_WAIT_L
#undef PG8_BAR
#undef PG8_SCHED
}
}
#include <hip/hip_cooperative_groups.h>
namespace cg = cooperative_groups;
#ifndef REP_ATTN
#define REP_ATTN 1
#endif
#ifndef REP_SYNC
#define REP_SYNC 1
#endif
#ifndef OLD_SEL
#define OLD_SEL 1
#endif
#ifndef REP_LN
#define REP_LN 1
#endif
#ifndef REP_NSI
#define REP_NSI 1
#endif
#ifndef REP_UP
#define REP_UP 1
#endif
#ifndef REP_GMI
#define REP_GMI 1
#endif
#ifndef REP_PRO
#define REP_PRO 1
#endif
#ifndef REP_GATE
#define REP_GATE 1
#endif
#ifndef REP_CMPR
#define REP_CMPR 1
#endif
#ifndef REP_CMP
#define REP_CMP 1
#endif
#ifndef REP_TOPK
#define REP_TOPK 1
#endif
#ifndef REP_SEL
#define REP_SEL 1
#endif
#ifndef REP_WIN
#define REP_WIN 1
#endif
typedef unsigned short bf16;
typedef float f32x4 __attribute__((ext_vector_type(4)));
typedef short bf16x8 __attribute__((ext_vector_type(8)));
typedef unsigned u32x4 __attribute__((ext_vector_type(4)));
typedef unsigned u32x2 __attribute__((ext_vector_type(2)));

constexpr int SEQ = 16384, MTOK = 32768, DM = 1024, DFF = 2816, GMW = 3072;
constexpr float ALPHA = 1.4142135623730951f;
constexpr float LN_EPS = 1e-5f;
constexpr size_t MiB = 1u << 20;
constexpr size_t WS_COS = 1 * MiB, WS_SIN = 3 * MiB, WS_CB = 5 * MiB;
constexpr size_t WS_ST = 5 * MiB + 512 * 1024;
constexpr size_t WS_W = 6 * MiB;
constexpr size_t W_FFN_STRIDE = 16 * MiB + MiB / 2;
constexpr size_t W_FFN_W2 = 11 * MiB;
constexpr size_t WS_GMI = WS_W + 66 * MiB, WS_GMO = WS_GMI + 12 * MiB, WS_NSI = WS_GMO + 6 * MiB, WS_NSO = WS_NSI + 5 * MiB + MiB / 2;
constexpr size_t WS_W1K = WS_NSO + 2 * MiB, WS_W1V = WS_W1K + 1 * MiB, WS_W2K = WS_W1V + 1 * MiB, WS_W2V = WS_W2K + MiB / 2;
constexpr size_t WS_XB = 102 * MiB, WS_R1 = 166 * MiB, WS_R2 = 358 * MiB, WS_PS = 454 * MiB, WS_END = 462 * MiB;
static_assert(WS_W2V + MiB / 2 <= WS_XB, "weights fit");
constexpr size_t R1_H = WS_R1;
constexpr size_t R1_U = WS_R1, R1_VT = WS_R1 + 96 * MiB;
constexpr size_t R1_Q = WS_R1, R1_KC = R1_Q + 64 * MiB, R1_VC = R1_KC + 16 * MiB, R1_KS = R1_VC + 16 * MiB, R1_VST = R1_KS + 16 * MiB,
                 R1_KW = R1_VST + 16 * MiB, R1_VWT = R1_KW + 16 * MiB, R1_GT = R1_VWT + 16 * MiB, R1_KCMP = R1_GT + 6 * MiB, R1_VCMPT = R1_KCMP + 1 * MiB;
static_assert(R1_VCMPT + 1 * MiB <= WS_R2, "R1 overlay");
constexpr int LDS_BYTES = 157696;
#define XCD_BAR_WORDS 3456

#define LAS __attribute__((address_space(3)))
#define GAS __attribute__((address_space(1)))
struct Params { const float* in[35]; float* out; unsigned char* ws; };
typedef const float* cfptr;
__device__ __forceinline__ const float* kin(int i) {
    const __attribute__((address_space(4))) cfptr* ka = (const __attribute__((address_space(4))) cfptr*)__builtin_amdgcn_kernarg_segment_ptr();
    return ka[i];
}

__device__ __forceinline__ unsigned f2bf(float f) { unsigned u = __builtin_bit_cast(unsigned, f); return (u + 0x7fffu + ((u >> 16) & 1u)) >> 16; }
__device__ __forceinline__ unsigned pk2(float lo, float hi) { return pg8::cvt_pk_bf16(lo, hi); }
__device__ __forceinline__ float bf2f(unsigned b) { return __builtin_bit_cast(float, b << 16); }
__device__ __forceinline__ float wave_sum(float v) {
#pragma unroll
    for (int o = 1; o < 64; o <<= 1) v += __shfl_xor(v, o);
    return v;
}
__device__ __forceinline__ unsigned char* launder_ptr(unsigned char* p) {
    const unsigned long long v = (unsigned long long)p; unsigned lo = (unsigned)v, hi = (unsigned)(v >> 32); asm volatile("" : "+v"(lo), "+v"(hi));
    lo = __builtin_amdgcn_readfirstlane(lo); hi = __builtin_amdgcn_readfirstlane(hi); return (unsigned char*)(((unsigned long long)hi << 32) | lo);
}
__device__ __forceinline__ f32x4 mfma16(bf16x8 a, bf16x8 b, f32x4 c) { return __builtin_amdgcn_mfma_f32_16x16x32_bf16(a, b, c, 0, 0, 0); }
using pg8::fast_exp;

__device__ __forceinline__ int srccol(int mode, int r) {
    if (mode == 0) return r;
    if (mode == 1) { const int pn = r >> 8, j = r & 255; return j < 128 ? 128 * pn + j : 2816 + 128 * pn + (j - 128); }
    const int tile = r >> 8, j = r & 255, half = j >> 7, jj = j & 127;
    if (tile < 4) return (4 * tile + (jj >> 5)) * 64 + (jj & 31) + 32 * half;
    if (tile == 4) return 1536 + (jj >> 5) * 64 + (jj & 31) + 32 * half;
    if (tile == 5) return 2048 + (jj >> 5) * 64 + (jj & 31) + 32 * half;
    if (tile == 6) return 1024 + j;
    if (tile == 7) return 1280 + j;
    if (tile == 8) return 1792 + j;
    if (tile == 9) return 2304 + j;
    return j < 48 ? 2560 + j : -1;
}
struct TItem { const GAS float* W; GAS bf16* WT; int K, Nsrc, mode, k0, n0; };
__device__ __forceinline__ void titem_load(const TItem& t, f32x4 (&v)[8], int lane) {
    const int c4 = lane & 7, kr = lane >> 3;
    const int sc = srccol(t.mode, t.n0 + 4 * c4);
#pragma unroll
    for (int i = 0; i < 8; ++i) { const int kk = kr + 8 * i;
        v[i] = sc >= 0 ? *(const GAS f32x4*)(t.W + (size_t)(t.k0 + kk) * t.Nsrc + sc) : (f32x4){0.f, 0.f, 0.f, 0.f}; }
}
__device__ __forceinline__ void titem_finish(const TItem& t, const f32x4 (&v)[8], LAS float* scr, int lane) {
    const int c4 = lane & 7, kr = lane >> 3;
#pragma unroll
    for (int i = 0; i < 8; ++i) { const int kk = kr + 8 * i; LAS float* d = scr + kk * 33 + 4 * c4; d[0] = v[i][0]; d[1] = v[i][1]; d[2] = v[i][2]; d[3] = v[i][3]; }
    asm volatile("s_waitcnt lgkmcnt(0)" ::: "memory");
    const int c = lane & 7;
#pragma unroll
    for (int j = 0; j < 4; ++j) { const int n = (lane >> 3) + 8 * j; const LAS float* s = scr + (8 * c) * 33 + n;
        u32x4 o; o.x = pk2(s[0 * 33], s[1 * 33]); o.y = pk2(s[2 * 33], s[3 * 33]); o.z = pk2(s[4 * 33], s[5 * 33]); o.w = pk2(s[6 * 33], s[7 * 33]);
        *(GAS u32x4*)(t.WT + (size_t)(t.n0 + n) * t.K + t.k0 + 8 * c) = o; }
    asm volatile("s_waitcnt lgkmcnt(0)" ::: "memory");
}
__device__ __forceinline__ void sincos_d(double rd, float& c, float& s) {
    const float r = (float)rd, r2 = r * r;
    float sv = -1.9572941e-20f;
    sv = sv * r2 + 8.2206352e-18f;
    sv = sv * r2 - 2.8114573e-15f;
    sv = sv * r2 + 7.6471637e-13f;
    sv = sv * r2 - 1.6059044e-10f;
    sv = sv * r2 + 2.5052108e-08f;
    sv = sv * r2 - 2.7557319e-06f;
    sv = sv * r2 + 1.9841270e-04f;
    sv = sv * r2 - 8.3333333e-03f;
    sv = sv * r2 + 1.6666667e-01f;
    sv = r - r * r2 * sv;
    float cv = 4.1103176e-19f;
    cv = cv * r2 - 1.5619207e-16f;
    cv = cv * r2 + 4.7794773e-14f;
    cv = cv * r2 - 1.1470746e-11f;
    cv = cv * r2 + 2.0876757e-09f;
    cv = cv * r2 - 2.7557319e-07f;
    cv = cv * r2 + 2.4801587e-05f;
    cv = cv * r2 - 1.3888889e-03f;
    cv = cv * r2 + 4.1666667e-02f;
    cv = cv * r2 - 0.5f;
    cv = cv * r2 + 1.0f;
    c = cv; s = sv;
}

__device__ __forceinline__ void prologue(const Params& p, unsigned char* lds, int tid, int lane, int wave) {
    unsigned char* ws = launder_ptr(p.ws);
    LAS float* scr = (LAS float*)((LAS unsigned char*)lds + wave * 16384);
    const int gw = blockIdx.x * 8 + wave, NGW = gridDim.x * 8;
    {
        constexpr int NI_IN = 16 * 176, NI_OUT = 44 * 32, NI_FFN = NI_IN + NI_OUT;
        constexpr int O_GMI = 4 * NI_FFN, O_GMO = O_GMI + 16 * 192, O_NSI = O_GMO + 48 * 32, O_NSO = O_NSI + 16 * 88, O_W1K = O_NSO + 16 * 32,
                      O_W1V = O_W1K + 32 * 8, O_W2K = O_W1V + 32 * 8, O_W2V = O_W2K + 4 * 2, NTOT = O_W2V + 4 * 2;
        auto decode = [&](int gi) -> TItem {
            TItem t; int it, Ndst;
            if (gi < O_GMI) { const int f = gi / NI_FFN, r = gi - f * NI_FFN; const int base = (f == 0 ? 1 : f == 1 ? 13 : f == 2 ? 17 : 31);
                if (r < NI_IN) { it = r; t.W = (const GAS float*)kin(base); t.K = 1024; t.Nsrc = 5632; Ndst = 5632; t.mode = 1; t.WT = (GAS bf16*)(ws + WS_W + f * W_FFN_STRIDE); }
                else { it = r - NI_IN; t.W = (const GAS float*)kin(base + 1); t.K = 2816; t.Nsrc = 1024; Ndst = 1024; t.mode = 0; t.WT = (GAS bf16*)(ws + WS_W + f * W_FFN_STRIDE + W_FFN_W2); } }
            else if (gi < O_GMO) { it = gi - O_GMI; t.W = (const GAS float*)kin(5);  t.K = 1024; t.Nsrc = 6144; Ndst = 6144; t.mode = 0; t.WT = (GAS bf16*)(ws + WS_GMI); }
            else if (gi < O_NSI) { it = gi - O_GMO; t.W = (const GAS float*)kin(10); t.K = 3072; t.Nsrc = 1024; Ndst = 1024; t.mode = 0; t.WT = (GAS bf16*)(ws + WS_GMO); }
            else if (gi < O_NSO) { it = gi - O_NSI; t.W = (const GAS float*)kin(21); t.K = 1024; t.Nsrc = 2608; Ndst = 2816; t.mode = 2; t.WT = (GAS bf16*)(ws + WS_NSI); }
            else if (gi < O_W1K) { it = gi - O_NSO; t.W = (const GAS float*)kin(28); t.K = 1024; t.Nsrc = 1024; Ndst = 1024; t.mode = 0; t.WT = (GAS bf16*)(ws + WS_NSO); }
            else if (gi < O_W1V) { it = gi - O_W1K; t.W = (const GAS float*)kin(23); t.K = 2048; t.Nsrc = 256;  Ndst = 256;  t.mode = 0; t.WT = (GAS bf16*)(ws + WS_W1K); }
            else if (gi < O_W2K) { it = gi - O_W1V; t.W = (const GAS float*)kin(26); t.K = 2048; t.Nsrc = 256;  Ndst = 256;  t.mode = 0; t.WT = (GAS bf16*)(ws + WS_W1V); }
            else if (gi < O_W2V) { it = gi - O_W2K; t.W = (const GAS float*)kin(24); t.K = 256;  t.Nsrc = 64;   Ndst = 64;   t.mode = 0; t.WT = (GAS bf16*)(ws + WS_W2K); }
            else                 { it = gi - O_W2V; t.W = (const GAS float*)kin(27); t.K = 256;  t.Nsrc = 64;   Ndst = 64;   t.mode = 0; t.WT = (GAS bf16*)(ws + WS_W2V); }
            const int nblk = Ndst / 32; t.k0 = 64 * (it / nblk); t.n0 = 32 * (it % nblk);
            return t;
        };
        if (gw < NTOT) {
            TItem cur = decode(gw); f32x4 vc[8]; titem_load(cur, vc, lane);
            for (int gi = gw; gi < NTOT; gi += NGW) {
                const bool more = gi + NGW < NTOT;
                TItem nxt = cur; f32x4 vn[8];
#pragma unroll
                for (int i = 0; i < 8; ++i) vn[i] = vc[i];
                if (more) { nxt = decode(gi + NGW); titem_load(nxt, vn, lane); }
                titem_finish(cur, vc, scr, lane);
                cur = nxt;
#pragma unroll
                for (int i = 0; i < 8; ++i) vc[i] = vn[i];
            }
        }
    }
    {
        const GAS f32x4* x4 = (const GAS f32x4*)kin(0); GAS u32x4* xb = (GAS u32x4*)(ws + WS_XB);
        const size_t n8 = (size_t)MTOK * DM / 8;
        for (size_t i = (size_t)blockIdx.x * 512 + tid; i < n8; i += (size_t)gridDim.x * 512) {
            const f32x4 a = x4[2 * i], b = x4[2 * i + 1];
            u32x4 o; o.x = pk2(a[0], a[1]); o.y = pk2(a[2], a[3]); o.z = pk2(b[0], b[1]); o.w = pk2(b[2], b[3]); xb[i] = o;
        }
    }
    {
        GAS float* cosT = (GAS float*)(ws + WS_COS); GAS float* sinT = (GAS float*)(ws + WS_SIN);
        for (int idx = blockIdx.x * 512 + tid; idx < SEQ * 32; idx += gridDim.x * 512) {
            const int pos = idx >> 5, i = idx & 31;
            double f = 1.0; const double r = 0.74989420933245582730;
            for (int k = 0; k < i; ++k) f *= r;
            const double ang = (double)pos * f;
            const double TWO_PI_HI = 6.283185307179586232, TWO_PI_LO = 2.4492935982947064e-16;
            const double kq = __builtin_rint(ang * 0.15915494309189533577);
            double rr = ang - kq * TWO_PI_HI; rr = rr - kq * TWO_PI_LO;
            float c, s; sincos_d(rr, c, s);
            cosT[idx] = c; sinT[idx] = s;
        }
    }
    if (blockIdx.x == 0 && tid == 0) *(GAS unsigned*)ws = 0u;
    if (blockIdx.x == 0) { GAS unsigned* bw = (GAS unsigned*)(ws + 16384); for (int i = tid; i < XCD_BAR_WORDS; i += 512) bw[i] = 0u; }
    {
        LAS float* rb = (LAS float*)lds;
        for (int c = blockIdx.x; c < 256; c += gridDim.x) {
            __syncthreads();
#pragma unroll
            for (int e = 0; e < 2; ++e) {
                const int oi = 2 * c + e, kv = oi >> 8, h = oi & 255;
                const GAS float* pe = (const GAS float*)kin(kv ? 25 : 22); const GAS float* w1 = (const GAS float*)kin(kv ? 26 : 23);
                float a = 0.f;
#pragma unroll
                for (int kk = 0; kk < 4; ++kk) { const int kx = tid + 512 * kk; a += pe[kx] * w1[(size_t)kx * 256 + h]; }
                rb[e * 512 + tid] = a;
            }
            __syncthreads();
            for (int sft = 256; sft > 0; sft >>= 1) {
                if (tid < sft) { rb[tid] += rb[tid + sft]; rb[512 + tid] += rb[512 + tid + sft]; }
                __syncthreads();
            }
            if (tid < 2) ((GAS float*)(ws + WS_CB))[2 * c + tid] = rb[tid * 512];
        }
    }
}

__device__ __forceinline__ float wave_sum_dpp(float v) {
#define LN_DPP(x, c) __builtin_bit_cast(float, __builtin_amdgcn_update_dpp(__builtin_bit_cast(int, x), __builtin_bit_cast(int, x), c, 0xf, 0xf, false))
    v += LN_DPP(v, 0x128); v += LN_DPP(v, 0x124); v += LN_DPP(v, 0x122); v += LN_DPP(v, 0x121);
#undef LN_DPP
    const int vi = __builtin_bit_cast(int, v);
    const float r0 = __builtin_bit_cast(float, __builtin_amdgcn_readlane(vi, 0)), r1 = __builtin_bit_cast(float, __builtin_amdgcn_readlane(vi, 16));
    const float r2 = __builtin_bit_cast(float, __builtin_amdgcn_readlane(vi, 32)), r3 = __builtin_bit_cast(float, __builtin_amdgcn_readlane(vi, 48));
    return (r0 + r1) + (r2 + r3);
}
template <int FINAL>
__device__ __forceinline__ void ln_phase(const GAS float* Y, GAS float* X, GAS bf16* XB, GAS float* ST, const GAS float* g, const GAS float* b, int lane, int wave) {
    typedef float f32x2e __attribute__((ext_vector_type(2)));
    const int gw = blockIdx.x * 8 + wave, NGW = gridDim.x * 8;
    f32x4 gv[4], bv[4];
#pragma unroll
    for (int j = 0; j < 4; ++j) { gv[j] = ((const GAS f32x4*)g)[lane + 64 * j]; bv[j] = ((const GAS f32x4*)b)[lane + 64 * j]; }
    f32x4 vn[4];
    { const GAS f32x4* xr = (const GAS f32x4*)(Y + (size_t)(gw < MTOK ? gw : 0) * DM) + lane;
#pragma unroll
      for (int j = 0; j < 4; ++j) vn[j] = xr[64 * j]; }
    for (int m = gw; m < MTOK; m += NGW) {
        f32x4 v[4]; float s = 0.f;
#pragma unroll
        for (int j = 0; j < 4; ++j) { v[j] = vn[j]; s += (v[j][0] + v[j][1]) + (v[j][2] + v[j][3]); }
        if (m + NGW < MTOK) { const GAS f32x4* xr = (const GAS f32x4*)(Y + (size_t)(m + NGW) * DM) + lane;
#pragma unroll
            for (int j = 0; j < 4; ++j) vn[j] = xr[64 * j]; }
        const float mean = wave_sum_dpp(s) * (1.f / DM); float s2 = 0.f;
#pragma unroll
        for (int j = 0; j < 4; ++j) { const f32x4 d = v[j] - mean; s2 += (d[0] * d[0] + d[1] * d[1]) + (d[2] * d[2] + d[3] * d[3]); }
        const float rstd = 1.f / sqrtf(wave_sum_dpp(s2) * (1.f / DM) + LN_EPS);
        if (FINAL) {
            GAS f32x4* xo = (GAS f32x4*)(X + (size_t)m * DM) + lane;
#pragma unroll
            for (int j = 0; j < 4; ++j) xo[64 * j] = (v[j] - mean) * rstd * gv[j] + bv[j];
        } else {
            if (lane == 0) *(GAS f32x2e*)(ST + (size_t)m * 2) = (f32x2e){mean, rstd};
            GAS u32x2* bo = (GAS u32x2*)(XB + (size_t)m * DM) + lane;
#pragma unroll
            for (int j = 0; j < 4; ++j) { const f32x4 o = (v[j] - mean) * rstd * gv[j] + bv[j]; u32x2 w; w.x = pk2(o[0], o[1]); w.y = pk2(o[2], o[3]); bo[64 * j] = w; }
        }
    }
}

__device__ __forceinline__ void gm_gate_phase(const GAS bf16* VT, const GAS bf16* U, GAS bf16* Gh, const GAS float* w_s, const GAS float* b_s, const GAS float* ln_g, const GAS float* ln_b, const GAS float* PS,
                                              unsigned char* lds, int tid, int lane, int wave) {
    LAS float* red = (LAS float*)lds;
    LAS float* stat = (LAS float*)((LAS unsigned char*)lds + 32768);
    for (int unit = blockIdx.x; unit < 256; unit += gridDim.x) {
        const int ch = unit >> 1, hh2 = unit & 1;
        const GAS bf16* vt = VT + (size_t)ch * 3072 * 128;
        {
            typedef float f32x2e __attribute__((ext_vector_type(2)));
            if (tid < 128) {
                const GAS f32x2e* pp = (const GAS f32x2e*)PS + (size_t)(ch * 128 + tid) * 48;
                float S = 0.f, Q = 0.f;
#pragma unroll 16
                for (int kx = 0; kx < 48; ++kx) { const f32x2e v = pp[kx]; S += v.x; Q += v.y; }
                const float mean = S * (1.f / 3072.f); const float var = Q * (1.f / 3072.f) - mean * mean;
                stat[tid] = mean; stat[128 + tid] = 1.f / sqrtf(var + LN_EPS);
            }
            __syncthreads();
        }
        const int tt = wave, n = lane & 15, kq = lane >> 4, t = 16 * tt + n;
        const int nks = (tt >> 1) + 1;
        LAS unsigned char* tb0 = (LAS unsigned char*)lds + 36864;
        constexpr int TROW = 272, TBUF = 192 * TROW;
        u32x4 tr[6];
#pragma unroll
        for (int q6 = 0; q6 < 6; ++q6) { const int q = tid + 512 * q6; tr[q6] = *(const GAS u32x4*)(vt + (size_t)((8 * hh2) * 192 + (q >> 4)) * 128 + (q & 15) * 8); }
#pragma unroll
        for (int q6 = 0; q6 < 6; ++q6) { const int q = tid + 512 * q6; *(LAS u32x4*)(tb0 + (q >> 4) * TROW + (q & 15) * 16) = tr[q6]; }
        __syncthreads();
        for (int gi = 0; gi < 8; ++gi) {
            const int g = 8 * hh2 + gi;
            if (gi + 1 < 8) {
#pragma unroll
                for (int q6 = 0; q6 < 6; ++q6) { const int q = tid + 512 * q6; tr[q6] = *(const GAS u32x4*)(vt + (size_t)((g + 1) * 192 + (q >> 4)) * 128 + (q & 15) * 8); }
            }
            const LAS unsigned char* tb = tb0 + (gi & 1) * TBUF;
            const GAS float* Wg = w_s + (size_t)g * 128 * 128 + (size_t)t * 128;
            bf16x8 bw[4]; float r0 = 0.f, r1 = 0.f;
#pragma unroll
            for (int ks = 0; ks < 4; ++ks) {
                bw[ks] = (bf16x8){0, 0, 0, 0, 0, 0, 0, 0};
                if (ks < nks) {
                    const int s0 = 32 * ks + 8 * kq;
                    const f32x4 wa = *(const GAS f32x4*)(Wg + s0), wb = *(const GAS f32x4*)(Wg + s0 + 4);
                    float w[8] = {wa[0], wa[1], wa[2], wa[3], wb[0], wb[1], wb[2], wb[3]};
                    unsigned hb[8];
#pragma unroll
                    for (int e = 0; e < 8; ++e) { const int s = s0 + e; const float wv = (s <= t) ? w[e] : 0.f; r0 += wv; const unsigned bb = f2bf(wv * stat[128 + s]); hb[e] = bb; r1 += bf2f(bb) * stat[s]; }
                    u32x4 pk; pk.x = hb[0] | (hb[1] << 16); pk.y = hb[2] | (hb[3] << 16); pk.z = hb[4] | (hb[5] << 16); pk.w = hb[6] | (hb[7] << 16);
                    bw[ks] = __builtin_bit_cast(bf16x8, pk);
                }
            }
            r0 += __shfl_xor(r0, 16); r0 += __shfl_xor(r0, 32); r1 += __shfl_xor(r1, 16); r1 += __shfl_xor(r1, 32);
            f32x4 acc[12];
#pragma unroll
            for (int ct = 0; ct < 12; ++ct) acc[ct] = (f32x4){0.f, 0.f, 0.f, 0.f};
#pragma unroll
            for (int ks = 0; ks < 4; ++ks) {
                if (ks < nks) {
#pragma unroll
                    for (int ct = 0; ct < 12; ++ct) {
                        const bf16x8 a = *(const LAS bf16x8*)(tb + (16 * ct + n) * TROW + 64 * ks + 16 * kq);
                        acc[ct] = mfma16(a, bw[ks], acc[ct]);
                    }
                }
            }
            const float bsv = b_s[g * 128 + t];
            const size_t rowoff = (size_t)(ch * 128 + t) * 3072;
#pragma unroll
            for (int ct = 0; ct < 12; ++ct) {
                const int cc = g * 192 + 16 * ct + 4 * kq;
                const f32x4 lg = *(const GAS f32x4*)(ln_g + cc), lb = *(const GAS f32x4*)(ln_b + cc);
                const u32x2 uu = *(const GAS u32x2*)(U + rowoff + cc);
                const float u0 = bf2f(uu.x & 0xffffu), u1 = bf2f(uu.x >> 16), u2 = bf2f(uu.y & 0xffffu), u3 = bf2f(uu.y >> 16);
                const float v0 = lg[0] * (acc[ct][0] - r1) + lb[0] * r0 + bsv, v1 = lg[1] * (acc[ct][1] - r1) + lb[1] * r0 + bsv;
                const float v2 = lg[2] * (acc[ct][2] - r1) + lb[2] * r0 + bsv, v3 = lg[3] * (acc[ct][3] - r1) + lb[3] * r0 + bsv;
                u32x2 o; o.x = pk2(u0 * v0, u1 * v1); o.y = pk2(u2 * v2, u3 * v3);
                *(GAS u32x2*)(Gh + rowoff + cc) = o;
            }
            if (gi + 1 < 8) {
                LAS unsigned char* tn = tb0 + ((gi + 1) & 1) * TBUF;
#pragma unroll
                for (int q6 = 0; q6 < 6; ++q6) { const int q = tid + 512 * q6; *(LAS u32x4*)(tn + (q >> 4) * TROW + (q & 15) * 16) = tr[q6]; }
            }
            __syncthreads();
        }
    }
}

__device__ __forceinline__ void compress_phase(const Params& p, unsigned char* lds, int tid, int lane, int wave) {
    unsigned char* ws = launder_ptr(p.ws);
    const GAS float* cosT = (const GAS float*)(ws + WS_COS); const GAS float* sinT = (const GAS float*)(ws + WS_SIN);
    const GAS float* cbg = (const GAS float*)(ws + WS_CB);
    LAS bf16* hball = (LAS bf16*)((LAS unsigned char*)lds + 2048);
    LAS unsigned char* wt0 = (LAS unsigned char*)lds + 36864;
    constexpr int WROW = 144, WBUF = 256 * WROW;
    const int r = lane & 15, kq = lane >> 4; const int rt = wave >> 1, hh = wave & 1;
    LAS bf16* hbuf = hball + rt * 16 * 264;
    for (int unit = blockIdx.x; unit < 256; unit += gridDim.x) {
        const int kv = unit >> 7, b = (unit >> 6) & 1, g = (unit >> 4) & 3, ntq = unit & 15;
        const int n0 = 64 * ntq + 16 * rt; const int nrow = n0 + r; const int nn = nrow < 1022 ? nrow : 1022;
        const GAS bf16* src = (const GAS bf16*)(ws + (kv ? R1_VC : R1_KC)) + ((size_t)(b * SEQ + 16 * nn)) * 256 + g * 64;
        const GAS bf16* W1t = (const GAS bf16*)(ws + (kv ? WS_W1V : WS_W1K));
        const GAS bf16* W2t = (const GAS bf16*)(ws + (kv ? WS_W2V : WS_W2K));
        f32x4 acc[8];
#pragma unroll
        for (int i = 0; i < 8; ++i) acc[i] = (f32x4){0.f, 0.f, 0.f, 0.f};
        u32x4 wr4[4];
#pragma unroll
        for (int q4 = 0; q4 < 4; ++q4) { const int q = tid + 512 * q4; wr4[q4] = *(const GAS u32x4*)(W1t + (size_t)(q >> 3) * 2048 + (q & 7) * 8); }
#pragma unroll
        for (int q4 = 0; q4 < 4; ++q4) { const int q = tid + 512 * q4; *(LAS u32x4*)(wt0 + (q >> 3) * WROW + (q & 7) * 16) = wr4[q4]; }
        __syncthreads();
        for (int kc = 0; kc < 32; ++kc) {
            if (kc + 1 < 32) {
#pragma unroll
                for (int q4 = 0; q4 < 4; ++q4) { const int q = tid + 512 * q4; wr4[q4] = *(const GAS u32x4*)(W1t + (size_t)(q >> 3) * 2048 + 64 * (kc + 1) + (q & 7) * 8); }
            }
            const LAS unsigned char* wt = wt0 + (kc & 1) * WBUF;
#pragma unroll
            for (int k2 = 0; k2 < 2; ++k2) {
                const int ks = 2 * kc + k2;
                const bf16x8 a = *(const GAS bf16x8*)(src + (size_t)(ks >> 1) * 256 + (ks & 1) * 32 + 8 * kq);
#pragma unroll
                for (int nt = 0; nt < 8; ++nt) {
                    const bf16x8 bfr = *(const LAS bf16x8*)(wt + (128 * hh + 16 * nt + r) * WROW + 64 * k2 + 16 * kq);
                    acc[nt] = mfma16(a, bfr, acc[nt]);
                }
            }
            if (kc + 1 < 32) {
                LAS unsigned char* wn = wt0 + ((kc + 1) & 1) * WBUF;
#pragma unroll
                for (int q4 = 0; q4 < 4; ++q4) { const int q = tid + 512 * q4; *(LAS u32x4*)(wn + (q >> 3) * WROW + (q & 7) * 16) = wr4[q4]; }
            }
            __syncthreads();
        }
#pragma unroll
        for (int nt = 0; nt < 8; ++nt) {
            const float bias = cbg[kv * 256 + 128 * hh + 16 * nt + r];
#pragma unroll
            for (int i = 0; i < 4; ++i) hbuf[(4 * kq + i) * 264 + 128 * hh + 16 * nt + r] = (bf16)f2bf(pg8::gelu_tanh_f(acc[nt][i] + bias));
        }
        __syncthreads();
        f32x4 o[2];
        o[0] = (f32x4){0.f, 0.f, 0.f, 0.f}; o[1] = (f32x4){0.f, 0.f, 0.f, 0.f};
#pragma unroll
        for (int k2 = 0; k2 < 8; ++k2) {
            const bf16x8 a = *(const LAS bf16x8*)(hbuf + r * 264 + 32 * k2 + 8 * kq);
#pragma unroll
            for (int e = 0; e < 2; ++e) {
                const bf16x8 bfr = *(const GAS bf16x8*)(W2t + (size_t)(16 * (hh + 2 * e) + r) * 256 + 32 * k2 + 8 * kq);
                o[e] = mfma16(a, bfr, o[e]);
            }
        }
#pragma unroll
        for (int i = 0; i < 4; ++i) {
            const int n = n0 + 4 * kq + i; const bool valid = n < 1023;
            if (kv == 0) {
                int pos = 16 * n + 31; if (pos > SEQ - 1) pos = SEQ - 1;
                GAS bf16* dst = (GAS bf16*)(ws + R1_KCMP) + ((size_t)(b * 4 + g) * 1024 + n) * 64;
                const int dl = 16 * hh + r; const float cs = cosT[pos * 32 + dl], sn = sinT[pos * 32 + dl];
                const float x1 = o[0][i], x2 = o[1][i];
                dst[dl] = valid ? (bf16)f2bf(x1 * cs - x2 * sn) : (bf16)0; dst[dl + 32] = valid ? (bf16)f2bf(x2 * cs + x1 * sn) : (bf16)0;
            } else {
                GAS bf16* dst = (GAS bf16*)(ws + R1_VCMPT) + (((size_t)(b * 4 + g) * 16 + (n >> 6)) * 64) * 64 + pg8::kpos64(n & 63);
#pragma unroll
                for (int e = 0; e < 2; ++e) dst[(size_t)(16 * (hh + 2 * e) + r) * 64] = valid ? (bf16)f2bf(o[e][i]) : (bf16)0;
            }
        }
        __syncthreads();
    }
}

typedef LAS unsigned char* ldsp_t;
typedef const LAS unsigned char* cldsp_t;
typedef const GAS bf16* gbf_t;
constexpr int A2_KV = 0, A2_IMP = 36864, A2_SEL = 102400, A2_PT = 104448 + 64, A2_PT2 = A2_PT + 8 * 2304, KROW = 144, KBUF = 9216;

template <int CTRL> __device__ __forceinline__ float dpp_f(float v) { return __builtin_bit_cast(float, __builtin_amdgcn_update_dpp(__builtin_bit_cast(int, v), __builtin_bit_cast(int, v), CTRL, 0xf, 0xf, false)); }
template <int CTRL> __device__ __forceinline__ unsigned dpp_u(unsigned v) { return (unsigned)__builtin_amdgcn_update_dpp((int)v, (int)v, CTRL, 0xf, 0xf, false); }
__device__ __forceinline__ float row16_max(float v) { v = fmaxf(v, dpp_f<0x128>(v)); v = fmaxf(v, dpp_f<0x124>(v)); v = fmaxf(v, dpp_f<0x122>(v)); v = fmaxf(v, dpp_f<0x121>(v)); return v; }
__device__ __forceinline__ float row16_sum(float v) { v += dpp_f<0x128>(v); v += dpp_f<0x124>(v); v += dpp_f<0x122>(v); v += dpp_f<0x121>(v); return v; }
__device__ __forceinline__ unsigned umax2(unsigned a, unsigned b) { return a > b ? a : b; }
__device__ __forceinline__ unsigned wave_max_u32(unsigned v) {
    v = umax2(v, dpp_u<0x111>(v)); v = umax2(v, dpp_u<0x112>(v)); v = umax2(v, dpp_u<0x114>(v)); v = umax2(v, dpp_u<0x118>(v));
    v = umax2(v, (unsigned)__builtin_amdgcn_update_dpp((int)v, (int)v, 0x142, 0xa, 0xf, false));
    v = umax2(v, (unsigned)__builtin_amdgcn_update_dpp((int)v, (int)v, 0x143, 0xc, 0xf, false));
    return (unsigned)__builtin_amdgcn_readlane((int)v, 63);
}

#define A2_BAR() asm volatile("s_waitcnt lgkmcnt(0)\n\ts_barrier" ::: "memory")
__device__ __forceinline__ float max3f(float a, float b, float c) { return fmaxf(fmaxf(a, b), c); }
template <int MODE, int PASS, int TSEL = -1>
__device__ __forceinline__ void attn_block(int kb, cldsp_t Kl, cldsp_t Vl, int t_base, ldsp_t lds, const bf16x8 (&qA)[2][2],
                                           float (&m)[2][4], float (&l)[2][4], const float (&il)[2][4], f32x4 (&o)[2][4], int lane, int wave, unsigned wsel = 0u) {
    const int n = lane & 15, rq = lane >> 4;
    LAS bf16* Pt = (LAS bf16*)(lds + A2_PT + wave * 2304);
    LAS float* imp = (LAS float*)(lds + A2_IMP);
    const LAS unsigned* selm = (const LAS unsigned*)(lds + A2_SEL);
#pragma unroll
    for (int T = 0; T < 2; ++T) {
        const int tq = t_base + 8 * wave + 4 * T + rq;
        bool sb = true;
        if (TSEL >= 0) { if (T != TSEL) continue; sb = ((wsel >> (kb & 31)) & 1u) != 0u; }
        else if (MODE == 2) { const unsigned wv = selm[(8 * wave + 4 * T + rq) * 8 + (kb >> 5)]; sb = ((wv >> (kb & 31)) & 1u) != 0u; if (__builtin_amdgcn_ballot_w64(sb) == 0ull) continue; }
        float pr[4][4];
        bool fast = false;
        if (PASS >= 2) {
            fast = (MODE == 0) ? (1024 * kb + 1039 <= t_base) : (MODE == 1) ? (64 * kb + 63 <= t_base && 64 * kb > t_base + 63 - 512) : (kb != (t_base >> 6));
            if (fast) {
                f32x4 ci;
#pragma unroll
                for (int i = 0; i < 4; ++i) ci[i] = sb ? -m[T][i] : -1e30f;
                f32x4 s[4];
#pragma unroll
                for (int j = 0; j < 4; ++j) {
                    cldsp_t kp = Kl + (16 * j + n) * KROW + 16 * rq;
                    s[j] = mfma16(qA[T][0], *(const LAS bf16x8*)kp, ci); s[j] = mfma16(qA[T][1], *(const LAS bf16x8*)(kp + 64), s[j]);
                }
                float mx = max3f(max3f(s[0][0], s[0][1], s[0][2]), max3f(s[0][3], s[1][0], s[1][1]), max3f(s[1][2], s[1][3], s[2][0]));
                mx = max3f(mx, max3f(s[2][1], s[2][2], s[2][3]), max3f(s[3][0], s[3][1], max3f(s[3][2], s[3][3], mx)));
                if (PASS != 2 && __builtin_amdgcn_ballot_w64(mx > 8.0f) != 0ull) fast = false;
                else {
#pragma unroll
                    for (int j = 0; j < 4; ++j)
#pragma unroll
                        for (int i = 0; i < 4; ++i) pr[j][i] = PASS == 2 ? __builtin_amdgcn_exp2f(s[j][i]) * il[T][i] : __builtin_amdgcn_exp2f(s[j][i]);
                    if (PASS != 2) {
#pragma unroll
                        for (int i = 0; i < 4; ++i) l[T][i] += (pr[0][i] + pr[1][i]) + (pr[2][i] + pr[3][i]);
                    }
                }
            }
        }
        if (!fast) {
            f32x4 s[4]; bool vis[4];
#pragma unroll
            for (int j = 0; j < 4; ++j) {
                cldsp_t kp = Kl + (16 * j + n) * KROW + 16 * rq;
                s[j] = (f32x4){0.f, 0.f, 0.f, 0.f};
                s[j] = mfma16(qA[T][0], *(const LAS bf16x8*)kp, s[j]); s[j] = mfma16(qA[T][1], *(const LAS bf16x8*)(kp + 64), s[j]);
                const int key = 64 * kb + 16 * j + n;
                vis[j] = MODE == 0 ? (16 * key + 31 <= tq) : MODE == 1 ? (key <= tq && key > tq - 512) : (sb && key <= tq);
            }
            if (PASS == 1) {
#pragma unroll
                for (int j = 0; j < 4; ++j)
                    if (vis[j]) {
#pragma unroll
                        for (int i = 0; i < 4; ++i) { const float mn = fmaxf(m[T][i], s[j][i]); l[T][i] = l[T][i] * __builtin_amdgcn_exp2f(m[T][i] - mn) + __builtin_amdgcn_exp2f(s[j][i] - mn); m[T][i] = mn; }
                    }
            } else if (PASS == 2) {
#pragma unroll
                for (int j = 0; j < 4; ++j)
#pragma unroll
                    for (int i = 0; i < 4; ++i) pr[j][i] = vis[j] ? __builtin_amdgcn_exp2f(s[j][i] - m[T][i]) * il[T][i] : 0.f;
            } else {
                float mn[4], al[4];
#pragma unroll
                for (int i = 0; i < 4; ++i) {
                    const float a0 = vis[0] ? s[0][i] : -1e30f, a1 = vis[1] ? s[1][i] : -1e30f, a2 = vis[2] ? s[2][i] : -1e30f, a3 = vis[3] ? s[3][i] : -1e30f;
                    const float tm = row16_max(fmaxf(fmaxf(a0, a1), fmaxf(a2, a3)));
                    mn[i] = (tm > m[T][i] + 8.0f || m[T][i] < -1e29f) ? fmaxf(m[T][i], tm) : m[T][i];
                    al[i] = __builtin_amdgcn_exp2f(m[T][i] - mn[i]); m[T][i] = mn[i];
                }
#pragma unroll
                for (int j = 0; j < 4; ++j)
#pragma unroll
                    for (int i = 0; i < 4; ++i) pr[j][i] = vis[j] ? __builtin_amdgcn_exp2f(s[j][i] - mn[i]) : 0.f;
#pragma unroll
                for (int i = 0; i < 4; ++i) {
                    l[T][i] = l[T][i] * al[i] + ((pr[0][i] + pr[1][i]) + (pr[2][i] + pr[3][i]));
                    if (PASS == 3) {
#pragma unroll
                        for (int dt = 0; dt < 4; ++dt) o[T][dt][i] *= al[i];
                    }
                }
            }
        }
        if (PASS == 2 || PASS == 3) {
#pragma unroll
            for (int c2 = 0; c2 < 2; ++c2) {
                LAS unsigned* pw32 = (LAS unsigned*)(Pt + (4 * rq) * 72 + 32 * c2 + 2 * n);
#pragma unroll
                for (int i = 0; i < 4; ++i) pw32[36 * i] = pk2(pr[2 * c2][i], pr[2 * c2 + 1][i]);
            }
#pragma unroll
            for (int j = 0; j < 4; ++j) {
                if (MODE == 0) {
                    const int key = 64 * kb + 16 * j + n;
                    const float ps = (pr[j][0] + pr[j][1]) + (pr[j][2] + pr[j][3]);
                    float qs = ps + dpp_f<0xB1>(ps); qs += dpp_f<0x4E>(qs);
                    if ((n & 3) == 3) { const int jj = key >> 2; LAS float* ip = imp + (8 * wave + 4 * T + rq) * 256;
                        (void)__hip_atomic_fetch_add(ip + jj, qs, __ATOMIC_RELAXED, __HIP_MEMORY_SCOPE_WORKGROUP); if (jj + 1 < 256) (void)__hip_atomic_fetch_add(ip + jj + 1, ps, __ATOMIC_RELAXED, __HIP_MEMORY_SCOPE_WORKGROUP); }
                }
            }
            bf16x8 vf[4][2];
#pragma unroll
            for (int dt = 0; dt < 4; ++dt) { cldsp_t vp = Vl + (16 * dt + n) * KROW + 16 * rq; vf[dt][0] = *(const LAS bf16x8*)vp; vf[dt][1] = *(const LAS bf16x8*)(vp + 64); }
            asm volatile("s_waitcnt lgkmcnt(0)" ::: "memory");
            const bf16x8 pa0 = *(const LAS bf16x8*)(Pt + n * 72 + 8 * rq), pa1 = *(const LAS bf16x8*)(Pt + n * 72 + 32 + 8 * rq);
#pragma unroll
            for (int dt = 0; dt < 4; ++dt) { o[T][dt] = mfma16(pa0, vf[dt][0], o[T][dt]); o[T][dt] = mfma16(pa1, vf[dt][1], o[T][dt]); }
            asm volatile("s_waitcnt lgkmcnt(0)" ::: "memory");
        }
    }
}

template <int MODE, int PASS>
__device__ __forceinline__ void attn_block2(int kb, cldsp_t Kl, cldsp_t Vl, int t_base, ldsp_t lds, const bf16x8 (&qA)[2][2],
                                            float (&m)[2][4], float (&l)[2][4], const float (&il)[2][4], f32x4 (&o)[2][4], float (&carry)[2], int lane, int wave) {
    const int n = lane & 15, rq = lane >> 4;
    LAS float* imp = (LAS float*)(lds + A2_IMP);
    const bool full = (MODE == 0) ? (1024 * kb + 1039 <= t_base) : (MODE == 1) ? (64 * kb + 63 <= t_base && 64 * kb > t_base + 63 - 512) : (kb != (t_base >> 6));
    bool sbt[2] = {true, true};
    if (MODE == 2) {
        const LAS unsigned* selm = (const LAS unsigned*)(lds + A2_SEL);
#pragma unroll
        for (int T = 0; T < 2; ++T) { const unsigned wv = selm[(8 * wave + 4 * T + rq) * 8 + (kb >> 5)]; sbt[T] = ((wv >> (kb & 31)) & 1u) != 0u; }
    }
    bf16x8 kf[4][2];
#pragma unroll
    for (int j = 0; j < 4; ++j) { cldsp_t kp = Kl + (16 * j + n) * KROW + 16 * rq; kf[j][0] = *(const LAS bf16x8*)kp; kf[j][1] = *(const LAS bf16x8*)(kp + 64); }
    f32x4 s[2][4];
    bool fast = full;
    if (fast) {
#pragma unroll
        for (int T = 0; T < 2; ++T) {
            f32x4 ci;
#pragma unroll
            for (int i = 0; i < 4; ++i) ci[i] = (MODE == 2 && !sbt[T]) ? -1e30f : -m[T][i];
#pragma unroll
            for (int j = 0; j < 4; ++j) { s[T][j] = mfma16(qA[T][0], kf[j][0], ci); s[T][j] = mfma16(qA[T][1], kf[j][1], s[T][j]); }
        }
        if (PASS != 2) {
            float mx = -1e30f;
#pragma unroll
            for (int T = 0; T < 2; ++T)
#pragma unroll
                for (int j = 0; j < 4; ++j) mx = max3f(mx, fmaxf(s[T][j][0], s[T][j][1]), fmaxf(s[T][j][2], s[T][j][3]));
            if (__builtin_amdgcn_ballot_w64(mx > 8.0f) != 0ull) fast = false;
        }
    }
    if (!fast) {
        const f32x4 z = (f32x4){0.f, 0.f, 0.f, 0.f};
#pragma unroll
        for (int T = 0; T < 2; ++T)
#pragma unroll
            for (int j = 0; j < 4; ++j) { s[T][j] = mfma16(qA[T][0], kf[j][0], z); s[T][j] = mfma16(qA[T][1], kf[j][1], s[T][j]); }
    }
#pragma unroll
    for (int T = 0; T < 2; ++T) {
        float pr[4][4];
        if (fast) {
#pragma unroll
            for (int j = 0; j < 4; ++j)
#pragma unroll
                for (int i = 0; i < 4; ++i) pr[j][i] = PASS == 2 ? __builtin_amdgcn_exp2f(s[T][j][i]) * il[T][i] : __builtin_amdgcn_exp2f(s[T][j][i]);
            if (PASS != 2) {
#pragma unroll
                for (int i = 0; i < 4; ++i) l[T][i] += (pr[0][i] + pr[1][i]) + (pr[2][i] + pr[3][i]);
            }
        } else {
            const int tq = t_base + 8 * wave + 4 * T + rq;
            bool vis[4];
#pragma unroll
            for (int j = 0; j < 4; ++j) { const int key = 64 * kb + 16 * j + n; vis[j] = MODE == 0 ? (16 * key + 31 <= tq) : MODE == 1 ? (key <= tq && key > tq - 512) : (sbt[T] && key <= tq); }
            if (PASS == 2) {
#pragma unroll
                for (int j = 0; j < 4; ++j)
#pragma unroll
                    for (int i = 0; i < 4; ++i) pr[j][i] = vis[j] ? __builtin_amdgcn_exp2f(s[T][j][i] - m[T][i]) * il[T][i] : 0.f;
            } else {
                float mn[4], al[4];
#pragma unroll
                for (int i = 0; i < 4; ++i) {
                    const float a0 = vis[0] ? s[T][0][i] : -1e30f, a1 = vis[1] ? s[T][1][i] : -1e30f, a2 = vis[2] ? s[T][2][i] : -1e30f, a3 = vis[3] ? s[T][3][i] : -1e30f;
                    const float tm = row16_max(fmaxf(fmaxf(a0, a1), fmaxf(a2, a3)));
                    mn[i] = (tm > m[T][i] + 8.0f || m[T][i] < -1e29f) ? fmaxf(m[T][i], tm) : m[T][i];
                    al[i] = __builtin_amdgcn_exp2f(m[T][i] - mn[i]); m[T][i] = mn[i];
                }
#pragma unroll
                for (int j = 0; j < 4; ++j)
#pragma unroll
                    for (int i = 0; i < 4; ++i) pr[j][i] = vis[j] ? __builtin_amdgcn_exp2f(s[T][j][i] - mn[i]) : 0.f;
#pragma unroll
                for (int i = 0; i < 4; ++i) {
                    l[T][i] = l[T][i] * al[i] + ((pr[0][i] + pr[1][i]) + (pr[2][i] + pr[3][i]));
                    if (PASS == 3) {
#pragma unroll
                        for (int dt = 0; dt < 4; ++dt) o[T][dt][i] *= al[i];
                    }
                }
            }
        }
        if (PASS == 2 || PASS == 3) {
            LAS bf16* Pt = (LAS bf16*)(lds + (T == 0 ? A2_PT : A2_PT2) + wave * 2304);
#pragma unroll
            for (int c2 = 0; c2 < 2; ++c2) {
                LAS unsigned* pw32 = (LAS unsigned*)(Pt + (4 * rq) * 72 + 32 * c2 + 2 * n);
#pragma unroll
                for (int i = 0; i < 4; ++i) pw32[36 * i] = pk2(pr[2 * c2][i], pr[2 * c2 + 1][i]);
            }
#pragma unroll
            for (int j = 0; j < 4; ++j) {
            }
            if (MODE == 0) {
                float rp_prev = carry[T];
                float binv[4];
#pragma unroll
                for (int j = 0; j < 4; ++j) {
                    const float ps = (pr[j][0] + pr[j][1]) + (pr[j][2] + pr[j][3]);
                    float qs = ps + dpp_f<0xB1>(ps); qs += dpp_f<0x4E>(qs);
                    const float rp = dpp_f<0x121>(ps);
                    binv[j] = qs + (n == 0 ? rp_prev : rp);
                    rp_prev = rp;
                }
                carry[T] = rp_prev;
                if ((n & 3) == 0) { LAS float* ip = imp + (8 * wave + 4 * T + rq) * 256 + 16 * kb + (n >> 2);
#pragma unroll
                    for (int j = 0; j < 4; ++j) ip[4 * j] = binv[j]; }
            }
        }
    }
    if (PASS == 2 || PASS == 3) {
        bf16x8 vf[4][2];
#pragma unroll
        for (int dt = 0; dt < 4; ++dt) { cldsp_t vp = Vl + (16 * dt + n) * KROW + 16 * rq; vf[dt][0] = *(const LAS bf16x8*)vp; vf[dt][1] = *(const LAS bf16x8*)(vp + 64); }
        asm volatile("s_waitcnt lgkmcnt(0)" ::: "memory");
#pragma unroll
        for (int T = 0; T < 2; ++T) {
            const LAS bf16* Pt = (const LAS bf16*)(lds + (T == 0 ? A2_PT : A2_PT2) + wave * 2304);
            const bf16x8 pa0 = *(const LAS bf16x8*)(Pt + n * 72 + 8 * rq), pa1 = *(const LAS bf16x8*)(Pt + n * 72 + 32 + 8 * rq);
#pragma unroll
            for (int dt = 0; dt < 4; ++dt) { o[T][dt] = mfma16(pa0, vf[dt][0], o[T][dt]); o[T][dt] = mfma16(pa1, vf[dt][1], o[T][dt]); }
        }
        asm volatile("s_waitcnt lgkmcnt(0)" ::: "memory");
    }
}

__device__ __forceinline__ unsigned opaque_u32(unsigned v) { asm volatile("" : "+v"(v)); return v; }
template <int MODE, int PASS>
__device__ __forceinline__ void attn_loop(gbf_t Kg, gbf_t VTg, int kb_lo, int kb_hi, int t_base, ldsp_t lds, const bf16x8 (&qA)[2][2],
                                          float (&m)[2][4], float (&l)[2][4], const float (&il)[2][4], f32x4 (&o)[2][4], int tid, int lane, int wave) {
    float carry[2] = {0.f, 0.f};
    constexpr int D = 2;
    constexpr bool HASV = !(PASS == 1 || PASS == 4);
    ldsp_t Kb0 = lds + A2_KV; ldsp_t Vb0 = lds + A2_KV + 2 * KBUF;
    const int soff = (tid >> 3) * KROW + (tid & 7) * 16;
    const unsigned goff = (unsigned)tid * 16u;
    const u32x4 zz = (u32x4){0u, 0u, 0u, 0u};
#define A2_LDK(kk) (*(const GAS u32x4*)((const GAS unsigned char*)(Kg + (size_t)(kk) * 4096) + opaque_u32(goff)))
#define A2_LDV(kk) (*(const GAS u32x4*)((const GAS unsigned char*)(VTg + (size_t)(kk) * 4096) + opaque_u32(goff)))
    u32x4 kr[D], vr[D];
#pragma unroll
    for (int s = 0; s < D; ++s) {
        kr[s] = zz; vr[s] = zz;
        if (kb_lo + s < kb_hi) { kr[s] = A2_LDK(kb_lo + s); if (HASV) vr[s] = A2_LDV(kb_lo + s); }
    }
    *(LAS u32x4*)(Kb0 + soff) = kr[0]; if (HASV) *(LAS u32x4*)(Vb0 + soff) = vr[0];
    if (kb_lo + D < kb_hi) { kr[0] = A2_LDK(kb_lo + D); if (HASV) vr[0] = A2_LDV(kb_lo + D); }
    A2_BAR();
    for (int kb4 = kb_lo; kb4 < kb_hi; kb4 += D) {
#pragma unroll
        for (int s = 0; s < D; ++s) {
            const int k = kb4 + s;
            if (k < kb_hi) {
                const int s1 = (s + 1) % D;
                if (k + 1 < kb_hi) { *(LAS u32x4*)(Kb0 + ((s + 1) & 1) * KBUF + soff) = kr[s1]; if (HASV) *(LAS u32x4*)(Vb0 + ((s + 1) & 1) * KBUF + soff) = vr[s1]; }
                if (k + 1 + D < kb_hi) { kr[s1] = A2_LDK(k + 1 + D); if (HASV) vr[s1] = A2_LDV(k + 1 + D); }
                if (MODE == 2) {
                    const LAS unsigned* selm_ = (const LAS unsigned*)(lds + A2_SEL);
                    const int rq_ = lane >> 4;
                    const unsigned w0_ = selm_[(8 * wave + rq_) * 8 + (k >> 5)], w1_ = selm_[(8 * wave + 4 + rq_) * 8 + (k >> 5)];
                    const bool h0_ = __builtin_amdgcn_ballot_w64(((w0_ >> (k & 31)) & 1u) != 0u) != 0ull, h1_ = __builtin_amdgcn_ballot_w64(((w1_ >> (k & 31)) & 1u) != 0u) != 0ull;
                    if (h0_ && h1_) attn_block2<MODE, PASS>(k, Kb0 + (s & 1) * KBUF, Vb0 + (s & 1) * KBUF, t_base, lds, qA, m, l, il, o, carry, lane, wave);
                    else if (h0_) attn_block<MODE, PASS, 0>(k, Kb0 + (s & 1) * KBUF, Vb0 + (s & 1) * KBUF, t_base, lds, qA, m, l, il, o, lane, wave, w0_);
                    else if (h1_) attn_block<MODE, PASS, 1>(k, Kb0 + (s & 1) * KBUF, Vb0 + (s & 1) * KBUF, t_base, lds, qA, m, l, il, o, lane, wave, w1_);
                } else attn_block2<MODE, PASS>(k, Kb0 + (s & 1) * KBUF, Vb0 + (s & 1) * KBUF, t_base, lds, qA, m, l, il, o, carry, lane, wave);
                A2_BAR();
            }
        }
    }
#undef A2_LDK
#undef A2_LDV
}

template <int MODE>
__device__ __forceinline__ void attn_branch(gbf_t Kg, gbf_t VTg, int kb_lo, int kb_hi, int t_base, ldsp_t lds, const bf16x8 (&qA)[2][2], f32x4 (&o)[2][4],
                                            const GAS float* gate0, int gidx, float gscale, int tid, int lane, int wave) {
    const int rq = lane >> 4;
    float m[2][4], l[2][4], il[2][4];
#pragma unroll
    for (int T = 0; T < 2; ++T) {
#pragma unroll
        for (int i = 0; i < 4; ++i) { m[T][i] = -1e30f; l[T][i] = 0.f; il[T][i] = 0.f; }
#pragma unroll
        for (int dt = 0; dt < 4; ++dt) o[T][dt] = (f32x4){0.f, 0.f, 0.f, 0.f};
    }
    if (MODE == 0) {
        attn_loop<MODE, 4>(Kg, VTg, kb_lo, kb_hi, t_base, lds, qA, m, l, il, o, tid, lane, wave);
#pragma unroll
        for (int T = 0; T < 2; ++T)
#pragma unroll
            for (int i = 0; i < 4; ++i) { const float ls = row16_sum(l[T][i]); il[T][i] = ls > 0.f ? 1.f / ls : 0.f; }
        attn_loop<MODE, 2>(Kg, VTg, kb_lo, kb_hi, t_base, lds, qA, m, l, il, o, tid, lane, wave);
#pragma unroll
        for (int T = 0; T < 2; ++T)
#pragma unroll
            for (int i = 0; i < 4; ++i) il[T][i] = 1.f;
    } else {
        attn_loop<MODE, 3>(Kg, VTg, kb_lo, kb_hi, t_base, lds, qA, m, l, il, o, tid, lane, wave);
#pragma unroll
        for (int T = 0; T < 2; ++T)
#pragma unroll
            for (int i = 0; i < 4; ++i) { const float ls = row16_sum(l[T][i]); il[T][i] = ls > 0.f ? 1.f / ls : 0.f; }
    }
#pragma unroll
    for (int T = 0; T < 2; ++T)
#pragma unroll
        for (int i = 0; i < 4; ++i) {
            const float gt = gate0[(size_t)(4 * T + rq) * 48 + i * 3 + gidx] * gscale * il[T][i];
#pragma unroll
            for (int dt = 0; dt < 4; ++dt) o[T][dt][i] *= gt;
        }
}

constexpr int A2_QS = A2_PT + 8 * 2304;
template <int Q>
__device__ __forceinline__ void sel_hit(int kb, bool diag, int t_base, ldsp_t lds, const bf16x8 (&kf)[4][2], cldsp_t Vl, f32x4& oq, f32x4& lq, int lane, int wave) {
    const int n = lane & 15, rq = lane >> 4;
    LAS bf16* Pq = (LAS bf16*)(lds + A2_PT + wave * 2304);
    LAS f32x4* mrefp = (LAS f32x4*)(lds + A2_PT + wave * 2304 + 1024) + Q;
    const LAS bf16* qp = (const LAS bf16*)(lds + A2_QS) + (8 * wave + Q) * 256 + (n & 3) * 64 + 8 * rq;
    const bf16x8 qf0 = *(const LAS bf16x8*)qp, qf1 = *(const LAS bf16x8*)(qp + 32);
    f32x4 mr = *mrefp;
    const int t = t_base + 8 * wave + Q; const int key = 64 * kb + 16 * rq + n;
    const bool vis = !diag || key <= t;
    const f32x4 ci = -mr;
    f32x4 c0 = mfma16(qf0, kf[0][0], ci), c1 = mfma16(qf0, kf[1][0], ci), c2 = mfma16(qf0, kf[2][0], ci), c3 = mfma16(qf0, kf[3][0], ci);
    c0 = mfma16(qf1, kf[0][1], c0); c1 = mfma16(qf1, kf[1][1], c1); c2 = mfma16(qf1, kf[2][1], c2); c3 = mfma16(qf1, kf[3][1], c3);
    f32x4 sp;
#pragma unroll
    for (int i = 0; i < 4; ++i) { const float v = rq == 0 ? c0[i] : rq == 1 ? c1[i] : rq == 2 ? c2[i] : c3[i]; sp[i] = vis ? v : -1e30f; }
    const float mx = max3f(sp[0], sp[1], fmaxf(sp[2], sp[3]));
    if (__builtin_amdgcn_ballot_w64(mx > 8.0f) != 0ull) {
        const f32x4 z = (f32x4){0.f, 0.f, 0.f, 0.f};
        c0 = mfma16(qf0, kf[0][0], z); c1 = mfma16(qf0, kf[1][0], z); c2 = mfma16(qf0, kf[2][0], z); c3 = mfma16(qf0, kf[3][0], z);
        c0 = mfma16(qf1, kf[0][1], c0); c1 = mfma16(qf1, kf[1][1], c1); c2 = mfma16(qf1, kf[2][1], c2); c3 = mfma16(qf1, kf[3][1], c3);
#pragma unroll
        for (int i = 0; i < 4; ++i) {
            const float v = rq == 0 ? c0[i] : rq == 1 ? c1[i] : rq == 2 ? c2[i] : c3[i];
            float hm = row16_max(vis ? v : -1e30f); hm = fmaxf(hm, __shfl_xor(hm, 16)); hm = fmaxf(hm, __shfl_xor(hm, 32));
            const float nr = (hm > mr[i] + 8.0f || mr[i] < -1e29f) ? fmaxf(mr[i], hm) : mr[i];
            const float al = __builtin_amdgcn_exp2f(mr[i] - nr);
            lq[i] *= al; oq[i] *= al; mr[i] = nr; sp[i] = vis ? v - nr : -1e30f;
        }
        if (lane == 0) *mrefp = mr;
    }
    f32x4 pv;
#pragma unroll
    for (int i = 0; i < 4; ++i) pv[i] = __builtin_amdgcn_exp2f(sp[i]);
    lq += pv;
    { const unsigned p01 = pk2(pv[0], pv[1]), p23 = pk2(pv[2], pv[3]);
      LAS bf16* pw = Pq + 16 * rq + n;
      pw[0] = (bf16)(p01 & 0xffffu); pw[72] = (bf16)(p01 >> 16); pw[144] = (bf16)(p23 & 0xffffu); pw[216] = (bf16)(p23 >> 16); }
    asm volatile("s_waitcnt lgkmcnt(0)" ::: "memory");
    const bf16x8 pa0 = *(const LAS bf16x8*)(Pq + (n & 3) * 72 + 8 * rq), pa1 = *(const LAS bf16x8*)(Pq + (n & 3) * 72 + 32 + 8 * rq);
    const f32x4 z = (f32x4){0.f, 0.f, 0.f, 0.f};
    bf16x8 vf[4][2];
#pragma unroll
    for (int j = 0; j < 4; ++j) { cldsp_t vp = Vl + (16 * j + n) * KROW + 16 * rq; vf[j][0] = *(const LAS bf16x8*)vp; vf[j][1] = *(const LAS bf16x8*)(vp + 64); }
    f32x4 o0 = mfma16(pa0, vf[0][0], z), o1 = mfma16(pa0, vf[1][0], z), o2 = mfma16(pa0, vf[2][0], z), o3 = mfma16(pa0, vf[3][0], z);
    o0 = mfma16(pa1, vf[0][1], o0); o1 = mfma16(pa1, vf[1][1], o1); o2 = mfma16(pa1, vf[2][1], o2); o3 = mfma16(pa1, vf[3][1], o3);
#pragma unroll
    for (int i = 0; i < 4; ++i) oq[i] += rq == 0 ? o0[i] : rq == 1 ? o1[i] : rq == 2 ? o2[i] : o3[i];
    asm volatile("s_waitcnt lgkmcnt(0)" ::: "memory");
}

__device__ __forceinline__ void sel_block(int kb, cldsp_t Kl, cldsp_t Vl, int t_base, ldsp_t lds, f32x4 (&o)[8], f32x4 (&l)[8], int lane, int wave) {
    const int n = lane & 15, rq = lane >> 4;
    const LAS unsigned* selm = (const LAS unsigned*)(lds + A2_SEL);
    unsigned wv = 0u; if (lane < 8) wv = selm[(8 * wave + lane) * 8 + (kb >> 5)];
    const unsigned qmask = (unsigned)__builtin_amdgcn_ballot_w64(((wv >> (kb & 31)) & 1u) != 0u) & 0xFFu;
    if (qmask == 0u) return;
    bf16x8 kf[4][2];
#pragma unroll
    for (int j = 0; j < 4; ++j) { cldsp_t kp = Kl + (16 * j + n) * KROW + 16 * rq; kf[j][0] = *(const LAS bf16x8*)kp; kf[j][1] = *(const LAS bf16x8*)(kp + 64); }
    const bool diag = kb == (t_base >> 6);
    if (qmask & 1u) sel_hit<0>(kb, diag, t_base, lds, kf, Vl, o[0], l[0], lane, wave);
    if (qmask & 2u) sel_hit<1>(kb, diag, t_base, lds, kf, Vl, o[1], l[1], lane, wave);
    if (qmask & 4u) sel_hit<2>(kb, diag, t_base, lds, kf, Vl, o[2], l[2], lane, wave);
    if (qmask & 8u) sel_hit<3>(kb, diag, t_base, lds, kf, Vl, o[3], l[3], lane, wave);
    if (qmask & 16u) sel_hit<4>(kb, diag, t_base, lds, kf, Vl, o[4], l[4], lane, wave);
    if (qmask & 32u) sel_hit<5>(kb, diag, t_base, lds, kf, Vl, o[5], l[5], lane, wave);
    if (qmask & 64u) sel_hit<6>(kb, diag, t_base, lds, kf, Vl, o[6], l[6], lane, wave);
    if (qmask & 128u) sel_hit<7>(kb, diag, t_base, lds, kf, Vl, o[7], l[7], lane, wave);
}

__device__ __forceinline__ void sel_branch(gbf_t Kg, gbf_t VTg, int kb_hi, int t_base, ldsp_t lds, const GAS float* gate0, float gscale, LAS float* stq, int tid, int lane, int wave) {
    const int n = lane & 15, rq = lane >> 4;
    constexpr int D = 2;
    ldsp_t Kb0 = lds + A2_KV; ldsp_t Vb0 = lds + A2_KV + 2 * KBUF;
    const int soff = (tid >> 3) * KROW + (tid & 7) * 16;
    const unsigned goff = (unsigned)tid * 16u;
    f32x4 o[8], l[8];
#pragma unroll
    for (int q = 0; q < 8; ++q) { o[q] = (f32x4){0.f, 0.f, 0.f, 0.f}; l[q] = (f32x4){0.f, 0.f, 0.f, 0.f}; }
    { float ng = -1e30f; asm volatile("" : "+v"(ng)); if (lane < 8) ((LAS f32x4*)(lds + A2_PT + wave * 2304 + 1024))[lane] = (f32x4){ng, ng, ng, ng}; }
#define S2_LDK(kk) (*(const GAS u32x4*)((const GAS unsigned char*)(Kg + (size_t)(kk) * 4096) + goff))
#define S2_LDV(kk) (*(const GAS u32x4*)((const GAS unsigned char*)(VTg + (size_t)(kk) * 4096) + goff))
    const u32x4 zz = (u32x4){0u, 0u, 0u, 0u};
    u32x4 kr[D], vr[D];
#pragma unroll
    for (int s = 0; s < D; ++s) { kr[s] = zz; vr[s] = zz; if (s < kb_hi) { kr[s] = S2_LDK(s); vr[s] = S2_LDV(s); } }
    *(LAS u32x4*)(Kb0 + soff) = kr[0]; *(LAS u32x4*)(Vb0 + soff) = vr[0];
    if (D < kb_hi) { kr[0] = S2_LDK(D); vr[0] = S2_LDV(D); }
    A2_BAR();
    for (int kb4 = 0; kb4 < kb_hi; kb4 += D) {
#pragma unroll
        for (int s = 0; s < D; ++s) {
            const int k = kb4 + s;
            if (k < kb_hi) {
                const int s1 = (s + 1) % D;
                if (k + 1 < kb_hi) { *(LAS u32x4*)(Kb0 + ((s + 1) & 1) * KBUF + soff) = kr[s1]; *(LAS u32x4*)(Vb0 + ((s + 1) & 1) * KBUF + soff) = vr[s1]; }
                if (k + 1 + D < kb_hi) { kr[s1] = S2_LDK(k + 1 + D); vr[s1] = S2_LDV(k + 1 + D); }
                sel_block(k, Kb0 + (s & 1) * KBUF, Vb0 + (s & 1) * KBUF, t_base, lds, o, l, lane, wave);
                A2_BAR();
            }
        }
    }
#undef S2_LDK
#undef S2_LDV
#pragma unroll
    for (int q = 0; q < 8; ++q)
#pragma unroll
        for (int i = 0; i < 4; ++i) {
            float ls = row16_sum(l[q][i]); ls += __shfl_xor(ls, 16); ls += __shfl_xor(ls, 32);
            const float sc = gate0[(size_t)q * 48 + i * 3 + 1] * gscale / ls;
            stq[(q * 4 + i) * 64 + 16 * rq + n] += o[q][i] * sc;
        }
}

__device__ __forceinline__ void attn_phase(const Params& p, ldsp_t lds, int tid, int lane, int wave) {
    unsigned char* ws = launder_ptr(p.ws);
    gbf_t Qr = (gbf_t)(ws + R1_Q);
    const GAS float* Gt = (const GAS float*)(ws + R1_GT);
    GAS bf16* O = (GAS bf16*)(ws + WS_R2);
    LAS float* imp = (LAS float*)(lds + A2_IMP);
    LAS unsigned* selm = (LAS unsigned*)(lds + A2_SEL);
    const int n = lane & 15, rq = lane >> 4;
    GAS unsigned* qctr = (GAS unsigned*)ws;
    volatile LAS int* ubox = (volatile LAS int*)(lds + A2_SEL + 2048);
    for (;;) {
        if (tid == 0) ubox[0] = (int)__hip_atomic_fetch_add(qctr, 1u, __ATOMIC_RELAXED, __HIP_MEMORY_SCOPE_AGENT);
        __syncthreads();
        const int u = __builtin_amdgcn_readfirstlane(ubox[0]);
        __syncthreads();
        if (u >= 2048) break;
        const int bg = u & 7; const int qb = 255 - (u >> 3);
        const int b = bg >> 2, g = bg & 3; const int t_base = 64 * qb; const int cur = qb;
        gbf_t KS = (gbf_t)(ws + R1_KS) + (size_t)bg * SEQ * 64;
        gbf_t VST = (gbf_t)(ws + R1_VST) + (size_t)bg * SEQ * 64;
        gbf_t KW = (gbf_t)(ws + R1_KW) + (size_t)bg * SEQ * 64;
        gbf_t VWT = (gbf_t)(ws + R1_VWT) + (size_t)bg * SEQ * 64;
        gbf_t KCMP = (gbf_t)(ws + R1_KCMP) + (size_t)bg * 1024 * 64;
        gbf_t VCMPT = (gbf_t)(ws + R1_VCMPT) + (size_t)bg * 1024 * 64;
        const GAS float* gate0 = Gt + (size_t)(b * SEQ + t_base + 8 * wave) * 48 + g * 12;
        { LAS u32x4* z = (LAS u32x4*)imp + wave * 512; const u32x4 zz = (u32x4){0u, 0u, 0u, 0u};
#pragma unroll
          for (int k = 0; k < 8; ++k) z[lane + 64 * k] = zz; }
        bf16x8 qA[2][2];
#pragma unroll
        for (int T = 0; T < 2; ++T) { gbf_t qp = Qr + (size_t)(b * SEQ + t_base + 8 * wave + 4 * T + (n >> 2)) * 1024 + (g * 4 + (n & 3)) * 64 + 8 * rq;
            qA[T][0] = *(const GAS bf16x8*)qp; qA[T][1] = *(const GAS bf16x8*)(qp + 32); }
        f32x4 oacc[2][4];
        LAS float* stq = imp + wave * 2048;
        { const int nv = 4 * qb + 3; const int nkb = (nv + 63) >> 6;
          attn_branch<0>(KCMP, VCMPT, 0, nkb, t_base, lds, qA, oacc, gate0, 0, 1.0f, tid, lane, wave);
          for (int rep_ = 1; rep_ < REP_CMP; ++rep_) { f32x4 o2[2][4]; attn_branch<0>(KCMP, VCMPT, 0, nkb, t_base, lds, qA, o2, gate0, 0, 0.0f, tid, lane, wave);
#pragma unroll
              for (int T = 0; T < 2; ++T)
#pragma unroll
                  for (int dt = 0; dt < 4; ++dt) oacc[T][dt] += o2[T][dt]; } }
#pragma unroll 1
        for (int qq_ = 0; qq_ < 2 * REP_TOPK; ++qq_) { const int qq = (qq_ & 1) * 4;
            unsigned kk[4][4], word[4];
#pragma unroll
            for (int e = 0; e < 4; ++e) { const int j = lane + 64 * e; const bool valid = (j >= 1) && (j <= cur - 2);
#pragma unroll
                for (int x = 0; x < 4; ++x) { float v = 0.f; if (valid) v = imp[(8 * wave + qq + x) * 256 + j];
                    kk[x][e] = valid ? ((__builtin_bit_cast(unsigned, v) & ~0xFFu) | (unsigned)(255 - j)) : 0u; } }
            unsigned w0 = 0u;
            if (lane == 0) w0 |= 1u;
            if (cur >= 1 && lane == (cur >> 5)) w0 |= 1u << (cur & 31);
            if (cur >= 2 && lane == ((cur - 1) >> 5)) w0 |= 1u << ((cur - 1) & 31);
#pragma unroll
            for (int x = 0; x < 4; ++x) word[x] = w0;
            const int ns0 = cur >= 2 ? 3 : (cur >= 1 ? 2 : 1);
            const int need = 16 - ns0;
            for (int it = 0; it < need; ++it) {
                unsigned wm[4];
#pragma unroll
                for (int x = 0; x < 4; ++x) wm[x] = wave_max_u32(umax2(umax2(kk[x][0], kk[x][1]), umax2(kk[x][2], kk[x][3])));
                if (wm[0] == 0u) break;
#pragma unroll
                for (int x = 0; x < 4; ++x) {
                    const int j = 255 - (int)(wm[x] & 0xFFu);
                    if (lane == (j >> 5)) word[x] |= 1u << (j & 31);
                    const bool mine = (lane == (j & 63));
#pragma unroll
                    for (int e = 0; e < 4; ++e) if (mine && e == (j >> 6)) kk[x][e] = 0u;
                }
            }
            if (lane < 8) {
#pragma unroll
                for (int x = 0; x < 4; ++x) selm[(8 * wave + qq + x) * 8 + lane] = word[x];
            }
        }
        asm volatile("s_waitcnt lgkmcnt(0)" ::: "memory");
#pragma unroll
        for (int T = 0; T < 2; ++T)
#pragma unroll
            for (int dt = 0; dt < 4; ++dt)
#pragma unroll
                for (int i = 0; i < 4; ++i) stq[((4 * T + rq) * 4 + i) * 64 + 16 * dt + n] = oacc[T][dt][i];
        { int lo = t_base - 511; if (lo < 0) lo = 0;
          for (int rep_ = 0; rep_ < REP_WIN; ++rep_) {
              attn_branch<1>(KW, VWT, lo >> 6, cur + 1, t_base, lds, qA, oacc, gate0, 2, 1.0f / REP_WIN, tid, lane, wave);
#pragma unroll
              for (int T = 0; T < 2; ++T)
#pragma unroll
                  for (int dt = 0; dt < 4; ++dt)
#pragma unroll
                      for (int i = 0; i < 4; ++i) stq[((4 * T + rq) * 4 + i) * 64 + 16 * dt + n] += oacc[T][dt][i];
          } }
        asm volatile("s_waitcnt lgkmcnt(0)" ::: "memory");
#if OLD_SEL
        { attn_branch<2>(KS, VST, 0, cur + 1, t_base, lds, qA, oacc, gate0, 1, 1.0f, tid, lane, wave);
#pragma unroll
          for (int T = 0; T < 2; ++T)
#pragma unroll
              for (int dt = 0; dt < 4; ++dt)
#pragma unroll
                  for (int i = 0; i < 4; ++i) stq[((4 * T + rq) * 4 + i) * 64 + 16 * dt + n] += oacc[T][dt][i]; }
#else
        for (int rep_ = 0; rep_ < REP_SEL; ++rep_) sel_branch(KS, VST, cur + 1, t_base, lds, gate0, 1.0f / REP_SEL, stq, tid, lane, wave);
#endif
        asm volatile("s_waitcnt lgkmcnt(0)" ::: "memory");
#pragma unroll
        for (int q = 0; q < 8; ++q) {
            const f32x4 v = *(const LAS f32x4*)(stq + q * 256 + 4 * lane);
            u32x2 w; w.x = pk2(v[0], v[1]); w.y = pk2(v[2], v[3]);
            *(GAS u32x2*)(O + (size_t)(b * SEQ + t_base + 8 * wave + q) * 1024 + g * 256 + 4 * lane) = w;
        }
    }
}

#define XB_TMO      128
#define XB_XCNT(j)  (256  + 64 * (j))
#define XB_XSUB(j)  (1280 + 64 * (j))
#define XB_XGEN(j)  (2304 + 64 * (j))
#define XB_TOP      3328
#define XB_TOPGEN   3392
#define XCD_BAR_WORDS 3456
#define XB_SPIN_CAP (1u << 18)

__device__ __forceinline__ unsigned xb_ld(unsigned* p)              { return __hip_atomic_load(p, __ATOMIC_RELAXED, __HIP_MEMORY_SCOPE_AGENT); }
__device__ __forceinline__ unsigned xb_add(unsigned* p, unsigned v) { return __hip_atomic_fetch_add(p, v, __ATOMIC_RELAXED, __HIP_MEMORY_SCOPE_AGENT); }
__device__ __forceinline__ unsigned xb_xcc_id() { return (unsigned)__builtin_amdgcn_s_getreg((3 << 11) | 20) & 0xFu; }
#define XB_SPIN(cond, bar) do { unsigned _sp = 0; while (cond) { __builtin_amdgcn_s_sleep(1); \
    if ((++_sp & 255u) == 0u) { if (xb_ld(&(bar)[XB_TMO])) break; if (_sp > XB_SPIN_CAP) { atomicAdd(&(bar)[XB_TMO], 1u); break; } } } } while (0)

struct XcdBarrier {
    unsigned* bar; unsigned x;
    volatile LAS unsigned* st;
};

__device__ __forceinline__ XcdBarrier xcd_barrier_post(unsigned* bar, volatile LAS unsigned* st) {
    XcdBarrier b; b.bar = bar; b.x = xb_xcc_id(); b.st = st;
    if (threadIdx.x == 0) (void)xb_add(&bar[XB_XCNT(b.x)], 1u);
    return b;
}
__device__ __forceinline__ void xcd_barrier_complete(unsigned* bar, unsigned x, unsigned& nloc, unsigned& nx) {
    const unsigned G = gridDim.x * gridDim.y * gridDim.z;
    unsigned sum, cnt, mine, sp = 0u;
    for (;;) {
        sum = 0u; cnt = 0u; mine = 0u;
#pragma unroll
        for (unsigned j = 0; j < 16; ++j) { const unsigned c = xb_ld(&bar[XB_XCNT(j)]); sum += c; cnt += (c > 0u) ? 1u : 0u; mine = (j == x) ? c : mine; }
        if (sum == G) break;
        __builtin_amdgcn_s_sleep(1);
        if ((++sp & 255u) == 0u) { if (xb_ld(&bar[XB_TMO])) break; if (sp > XB_SPIN_CAP) { atomicAdd(&bar[XB_TMO], 1u); break; } }
    }
    nloc = mine > 0u ? mine : 1u; nx = cnt > 0u ? cnt : 1u;
}

__device__ __forceinline__ void xcd_barrier(const XcdBarrier& b) {
    asm volatile("s_waitcnt vmcnt(0)" ::: "memory");
    __syncthreads();
    if (threadIdx.x == 0) {
        unsigned* bar = b.bar;
        __builtin_amdgcn_s_waitcnt(0);
        unsigned nloc = b.st[0], nx = b.st[1];
        if (nloc == 0u) { xcd_barrier_complete(bar, b.x, nloc, nx); b.st[0] = nloc; b.st[1] = nx; }
        const unsigned old = xb_add(&bar[XB_XSUB(b.x)], 1u);
        const unsigned gen = old / nloc;
        if (old + 1u == (gen + 1u) * nloc) {
            __builtin_amdgcn_fence(__ATOMIC_RELEASE, "agent");
            asm volatile("s_waitcnt vmcnt(0)" ::: "memory");
            const unsigned og = xb_add(&bar[XB_TOP], 1u);
            const unsigned tg = og / nx;
            if (og + 1u == (tg + 1u) * nx) xb_add(&bar[XB_TOPGEN], 1u);
            else XB_SPIN(xb_ld(&bar[XB_TOPGEN]) == tg, bar);
            __builtin_amdgcn_fence(__ATOMIC_ACQUIRE, "agent");
            xb_add(&bar[XB_XGEN(b.x)], 1u);
            asm volatile("s_waitcnt vmcnt(0)" ::: "memory");
        } else {
            XB_SPIN(xb_ld(&bar[XB_XGEN(b.x)]) == gen, bar);
            __builtin_amdgcn_fence(__ATOMIC_ACQUIRE, "agent");
            asm volatile("s_waitcnt vmcnt(0)" ::: "memory");
        }
    }
    __syncthreads();
}

constexpr size_t WS_BAR = 16384;
constexpr int LDS_BARST = 156160;

__global__ void __launch_bounds__(512, 2) mega(Params p) {
    extern __shared__ __attribute__((aligned(16))) unsigned char lds[];
    cg::grid_group grid = cg::this_grid();
    PG8_LAS unsigned char* glds = (PG8_LAS unsigned char*)lds;
    const int G = gridDim.x, c = blockIdx.x;
    volatile LAS unsigned* barst = (volatile LAS unsigned*)(glds + LDS_BARST);
    if (threadIdx.x < 2) barst[threadIdx.x] = 0u;
    __syncthreads();
    XcdBarrier xbar; xbar.bar = (unsigned*)(p.ws + WS_BAR); xbar.x = 0; xbar.st = barst;
    for (int st = 0; st < 25; ++st) {
        int tid_l = threadIdx.x; asm volatile("" : "+v"(tid_l));
        const int tid = tid_l, lane = tid & 63, wave = __builtin_amdgcn_readfirstlane(tid >> 6);
        unsigned char* ws;
        { const unsigned long long wsv = (unsigned long long)p.ws; unsigned lo = (unsigned)wsv, hi = (unsigned)(wsv >> 32); asm volatile("" : "+v"(lo), "+v"(hi));
          lo = __builtin_amdgcn_readfirstlane(lo); hi = __builtin_amdgcn_readfirstlane(hi); ws = (unsigned char*)(((unsigned long long)hi << 32) | lo); }
        bf16* XB = (bf16*)(ws + WS_XB);
        int kind, a = 0;
        switch (st) {
            case 0: kind = 0; break;
            case 1: kind = 1; a = 0; break;  case 2: kind = 2; a = 0; break;  case 3: kind = 3; a = 3; break;
            case 4: kind = 4; a = 0; break;  case 5: kind = 5; a = 0; break;  case 6: kind = 6; a = 0; break;
            case 7: kind = 4; a = 1; break;  case 8: kind = 5; a = 1; break;  case 9: kind = 6; a = 1; break;
            case 10: kind = 3; a = 11; break;
            case 11: kind = 1; a = 1; break; case 12: kind = 2; a = 1; break; case 13: kind = 3; a = 15; break;
            case 14: kind = 1; a = 2; break; case 15: kind = 2; a = 2; break; case 16: kind = 3; a = 19; break;
            case 17: kind = 7; break; case 18: kind = 8; break; case 19: kind = 9; break; case 20: kind = 10; break;
            case 21: kind = 3; a = 29; break;
            case 22: kind = 1; a = 3; break; case 23: kind = 2; a = 3; break; default: kind = 3; a = 33; break;
        }
        if (kind == 0) {
            for (int r_ = 0; r_ < REP_PRO; ++r_) prologue(p, lds, tid, lane, wave);
        } else if (kind == 1) {
            pg8::Gemm g{XB, (const bf16*)(ws + WS_W + a * W_FFN_STRIDE), MTOK, 2 * DFF, DM}; pg8::StaticOrder S; S.init(MTOK, 2 * DFF, G, c);
            pg8::EpiSwiglu E{(bf16*)(ws + R1_H), DFF};
            for (int r_ = 0; r_ < REP_UP; ++r_) pg8::gemm_phase<pg8::EpiSwiglu, pg8::StaticOrder, true, true>(glds, g, S, E);
        } else if (kind == 2 || kind == 6 || kind == 10) {
            const bf16* A_; const bf16* B_; int M_, K_; const float* R_; float* Y_; float sc_;
            if (kind == 2) { A_ = (const bf16*)(ws + R1_H); B_ = (const bf16*)(ws + WS_W + a * W_FFN_STRIDE + W_FFN_W2); M_ = MTOK; K_ = DFF; R_ = (a == 0 ? kin(0) : (const float*)p.out); Y_ = p.out; sc_ = 0.5f; }
            else if (kind == 6) { A_ = (const bf16*)(ws + WS_R2); B_ = (const bf16*)(ws + WS_GMO); M_ = 16384; K_ = GMW; Y_ = p.out + (size_t)a * 16384 * DM; R_ = Y_; sc_ = 1.0f; }
            else { A_ = (const bf16*)(ws + WS_R2); B_ = (const bf16*)(ws + WS_NSO); M_ = MTOK; K_ = DM; R_ = p.out; Y_ = p.out; sc_ = 1.0f; }
            pg8::Gemm g{A_, B_, M_, DM, K_}; pg8::StaticOrder S; S.init(M_, DM, G, c);
            pg8::EpiRes E{kind * 8 + a};
#ifndef NO_K2
            pg8::gemm_phase<pg8::EpiRes, pg8::StaticOrder, true, true>(glds, g, S, E);
#endif
        } else if (kind == 3) {
            if (a == 33) ln_phase<1>((const GAS float*)p.out, (GAS float*)p.out, (GAS bf16*)XB, (GAS float*)(ws + WS_ST), (const GAS float*)kin(a), (const GAS float*)kin(a + 1), lane, wave);
            else for (int r_ = 0; r_ < REP_LN; ++r_) ln_phase<0>((const GAS float*)p.out, (GAS float*)p.out, (GAS bf16*)XB, (GAS float*)(ws + WS_ST), (const GAS float*)kin(a), (const GAS float*)kin(a + 1), lane, wave);
        } else if (kind == 4) {
            pg8::Gemm g{XB + (size_t)a * 16384 * DM, (const bf16*)(ws + WS_GMI), 16384, 2 * GMW, DM}; pg8::StaticOrder S; S.init(16384, 2 * GMW, G, c);
            pg8::EpiGm E{(bf16*)(ws + R1_U), (bf16*)(ws + R1_VT), (float*)(ws + WS_PS)};
            for (int r_ = 0; r_ < REP_GMI; ++r_) pg8::gemm_phase<pg8::EpiGm, pg8::StaticOrder, true, true>(glds, g, S, E);
        } else if (kind == 5) {
            for (int r_ = 0; r_ < REP_GATE; ++r_) gm_gate_phase((const GAS bf16*)(ws + R1_VT), (const GAS bf16*)(ws + R1_U), (GAS bf16*)(ws + WS_R2), (const GAS float*)kin(8), (const GAS float*)kin(9), (const GAS float*)kin(6), (const GAS float*)kin(7), (const GAS float*)(ws + WS_PS), lds, tid, lane, wave);
        } else if (kind == 7) {
            pg8::Gemm g{XB, (const bf16*)(ws + WS_NSI), MTOK, 2816, DM}; pg8::StaticOrder S; S.init(MTOK, 2816, G, c);
            pg8::EpiNsa E{(bf16*)(ws + R1_Q), (bf16*)(ws + R1_KC), (bf16*)(ws + R1_VC), (bf16*)(ws + R1_KS), (bf16*)(ws + R1_VST), (bf16*)(ws + R1_KW), (bf16*)(ws + R1_VWT),
                          (float*)(ws + R1_GT), (const float*)(ws + WS_COS), (const float*)(ws + WS_SIN)};
            for (int r_ = 0; r_ < REP_NSI; ++r_) pg8::gemm_phase<pg8::EpiNsa, pg8::StaticOrder, true, true>(glds, g, S, E);
        } else if (kind == 8) {
            for (int r_ = 0; r_ < REP_CMPR; ++r_) compress_phase(p, lds, tid, lane, wave);
        } else if (kind == 9) {
            for (int rep_ = 0; rep_ < REP_ATTN; ++rep_) {
                if (rep_ > 0) { xcd_barrier(xbar); if (blockIdx.x == 0 && tid == 0) *(GAS unsigned*)ws = 0u; xcd_barrier(xbar); }
                attn_phase(p, (ldsp_t)lds, tid, lane, wave);
            }
        }
        if (st == 0) { grid.sync(); xbar = xcd_barrier_post((unsigned*)(p.ws + WS_BAR), barst); }
        else if (st != 24) { xcd_barrier(xbar); for (int r_ = 1; r_ < REP_SYNC; ++r_) xcd_barrier(xbar); }
    }
}

extern "C" void kernel_launch(void* const* d_in, const int* in_sizes, int n_in, void* d_out, int out_size, void* d_ws, size_t ws_size, hipStream_t stream) {
    static int grid = 0;
    if (grid == 0) {
        if (n_in != 35 || ws_size < WS_END) { fprintf(stderr, "kernel_launch: unexpected n_in %d / ws %zu\n", n_in, ws_size); grid = -1; return; }
        int dev = 0, cus = 0, per_cu = 0;
        hipGetDevice(&dev); hipDeviceGetAttribute(&cus, hipDeviceAttributeMultiprocessorCount, dev);
        hipFuncSetAttribute((const void*)mega, hipFuncAttributeMaxDynamicSharedMemorySize, LDS_BYTES);
        hipOccupancyMaxActiveBlocksPerMultiprocessor(&per_cu, (const void*)mega, 512, LDS_BYTES);
        if (per_cu < 1) per_cu = 1;
        (void)hipGetLastError();
        grid = cus * per_cu;
    }
    if (grid < 0) return;
    Params p{};
    for (int i = 0; i < 35; ++i) p.in[i] = (const float*)d_in[i];
    p.out = (float*)d_out; p.ws = (unsigned char*)d_ws;
    void* args[] = {&p};
    hipError_t e = hipLaunchCooperativeKernel((void*)mega, dim3(grid), dim3(512), args, LDS_BYTES, stream);
    if (e != hipSuccess) fprintf(stderr, "cooperative launch failed: %s (grid %d)\n", hipGetErrorString(e), grid);
}
```
